# Optimizing an MI355X kernel written in HIP

```python
import jax, jax.numpy as jnp
from jax import lax
import numpy as np

D_MODEL = 1024
BATCH = 8
SEQ = 8192
DEPTH = 1

N_MEM = 256
EPS = 1e-6
FOX_HEADS = 8
FOX_HEAD_DIM = 64
FOX_WIDTH = FOX_HEADS * FOX_HEAD_DIM
Q_BLOCK = 128
GDN_HEADS = 4
GDN_HEAD_DIM = 128
GDN_WIDTH = GDN_HEADS * GDN_HEAD_DIM
CONV_WIDTH = 4
CHUNK = 64
MIX_WIDTH = FOX_WIDTH + GDN_WIDTH
IN_PROJ_SIZES = (FOX_WIDTH, FOX_WIDTH, FOX_WIDTH, FOX_HEADS,
                 GDN_WIDTH, GDN_WIDTH, GDN_WIDTH, GDN_WIDTH, GDN_HEADS, GDN_HEADS)
IN_PROJ_WIDTH = sum(IN_PROJ_SIZES)
SPLIT_POINTS = tuple(np.cumsum(IN_PROJ_SIZES)[:-1].tolist())
MEM_HEADS = 4
MEM_HEAD_DIM = D_MODEL // MEM_HEADS
D_FF = 2816
FFN_RESIDUAL_WEIGHT = 0.5

kernel_name = 'hymba_fox_gdn_macaron_sandwich_memory'


def rms_norm(x, gain):
    xf = x.astype(jnp.float32)
    y = xf * lax.rsqrt(jnp.mean(xf * xf, axis=-1, keepdims=True) + EPS)
    return (y * gain.astype(jnp.float32)).astype(x.dtype)


def l2_norm(x):
    return x * lax.rsqrt(jnp.sum(x * x, axis=-1, keepdims=True) + EPS)


def swiglu(x, w_gate, w_up, w_down):
    return (jax.nn.silu(x @ w_gate) * (x @ w_up)) @ w_down


def forgetting_attention(q, k, v, f_logit):
    B, S, H, Dh = q.shape
    nb = S // Q_BLOCK
    F = jnp.cumsum(jax.nn.log_sigmoid(f_logit.astype(jnp.float32)), axis=1).transpose(0, 2, 1)
    qb = (q * (Dh ** -0.5)).reshape(B, nb, Q_BLOCK, H, Dh).transpose(1, 0, 3, 2, 4)
    Fq = F.reshape(B, H, nb, Q_BLOCK).transpose(2, 0, 1, 3)
    q_pos = jnp.arange(S).reshape(nb, Q_BLOCK)
    k_pos = jnp.arange(S)

    def block(args):
        q_blk, F_blk, pos_blk = args
        s = jnp.einsum('bhqd,bshd->bhqs', q_blk, k, preferred_element_type=jnp.float32)
        s = s + F_blk[..., None] - F[:, :, None, :]
        s = jnp.where(pos_blk[:, None] >= k_pos[None, :], s, -jnp.inf)
        p = jax.nn.softmax(s, axis=-1).astype(v.dtype)
        return jnp.einsum('bhqs,bshd->bqhd', p, v)

    out = lax.map(block, (qb, Fq, q_pos))
    return out.transpose(1, 0, 2, 3, 4).reshape(B, S, H * Dh)


def causal_conv_silu(x, w):
    S = x.shape[1]
    xp = jnp.pad(x, ((0, 0), (CONV_WIDTH - 1, 0), (0, 0)))
    y = xp[:, 0:S] * w[0]
    for i in range(1, CONV_WIDTH):
        y = y + xp[:, i:i + S] * w[i]
    return jax.nn.silu(y)


def gated_delta_rule_chunked(q, k, v, g, beta):
    B, S, H, Dk = q.shape
    Dv = v.shape[-1]
    n = S // CHUNK

    def chunks(t):
        return t.reshape(B, n, CHUNK, H, -1).transpose(0, 3, 1, 2, 4)

    q = chunks(q) * (Dk ** -0.5)
    k = chunks(k)
    v = chunks(v)
    beta = beta.reshape(B, n, CHUNK, H).transpose(0, 3, 1, 2)
    g = jnp.cumsum(g.reshape(B, n, CHUNK, H).transpose(0, 3, 1, 2), axis=-1)
    k_beta = k * beta[..., None]
    v_beta = v * beta[..., None]
    incl = jnp.tril(jnp.ones((CHUNK, CHUNK), dtype=bool))
    strict = jnp.tril(jnp.ones((CHUNK, CHUNK), dtype=bool), -1)
    decay = jnp.exp(jnp.where(incl, g[..., :, None] - g[..., None, :], -jnp.inf))
    L = jnp.where(strict, jnp.einsum('bhncd,bhnsd->bhncs', k_beta, k) * decay, 0.0)
    A = L + jnp.eye(CHUNK, dtype=L.dtype)
    u = lax.linalg.triangular_solve(A, v_beta, left_side=True, lower=True)
    w = lax.linalg.triangular_solve(A, k_beta * jnp.exp(g)[..., None], left_side=True, lower=True)
    attn_intra = jnp.einsum('bhncd,bhnsd->bhncs', q, k) * decay
    q_decay = q * jnp.exp(g)[..., None]
    g_last = g[..., -1]
    k_tail = k * jnp.exp(g_last[..., None] - g)[..., None]

    def step(state, xs):
        w_c, u_c, qd_c, a_c, kt_c, gl_c = xs
        v_new = u_c - jnp.einsum('bhcd,bhde->bhce', w_c, state)
        o = jnp.einsum('bhcd,bhde->bhce', qd_c, state) + jnp.einsum('bhcs,bhse->bhce', a_c, v_new)
        state = state * jnp.exp(gl_c)[..., None, None] + jnp.einsum('bhcd,bhce->bhde', kt_c, v_new)
        return state, o

    xs = (jnp.moveaxis(w, 2, 0), jnp.moveaxis(u, 2, 0), jnp.moveaxis(q_decay, 2, 0),
          jnp.moveaxis(attn_intra, 2, 0), jnp.moveaxis(k_tail, 2, 0), jnp.moveaxis(g_last, 2, 0))
    state0 = jnp.zeros((B, H, Dk, Dv), jnp.float32)
    _, o = lax.scan(step, state0, xs)
    return o.transpose(1, 0, 3, 2, 4).reshape(B, S, H, Dv)


def hybrid_mixer(u, w_in, fox_f_bias, gdn_conv_w, gdn_a_log, gdn_dt_bias, gdn_out_norm):
    B, S, _ = u.shape
    proj = u @ w_in
    fq, fk, fv, ff, gq, gk, gv, gz, gb, ga = jnp.split(proj, SPLIT_POINTS, axis=-1)
    fox = forgetting_attention(fq.reshape(B, S, FOX_HEADS, FOX_HEAD_DIM),
                               fk.reshape(B, S, FOX_HEADS, FOX_HEAD_DIM),
                               fv.reshape(B, S, FOX_HEADS, FOX_HEAD_DIM),
                               ff + fox_f_bias)
    qkv = causal_conv_silu(jnp.concatenate([gq, gk, gv], axis=-1).astype(jnp.float32),
                           gdn_conv_w.astype(jnp.float32))
    cq, ck, cv = jnp.split(qkv, (GDN_WIDTH, 2 * GDN_WIDTH), axis=-1)
    q = l2_norm(cq.reshape(B, S, GDN_HEADS, GDN_HEAD_DIM))
    k = l2_norm(ck.reshape(B, S, GDN_HEADS, GDN_HEAD_DIM))
    v = cv.reshape(B, S, GDN_HEADS, GDN_HEAD_DIM)
    beta = jax.nn.sigmoid(gb.astype(jnp.float32))
    g = -jnp.exp(gdn_a_log.astype(jnp.float32)) * jax.nn.softplus(
        ga.astype(jnp.float32) + gdn_dt_bias.astype(jnp.float32))
    o = gated_delta_rule_chunked(q, k, v, g, beta)
    o = rms_norm(o, gdn_out_norm) * jax.nn.silu(
        gz.astype(jnp.float32).reshape(B, S, GDN_HEADS, GDN_HEAD_DIM))
    gdn = o.reshape(B, S, GDN_WIDTH).astype(u.dtype)
    return jnp.concatenate([fox.astype(u.dtype), gdn], axis=-1)


def memory_cross_attention(h, m, w_q, w_kv, w_o):
    B, S, _ = h.shape
    q = (h @ w_q).reshape(B, S, MEM_HEADS, MEM_HEAD_DIM)
    k, v = jnp.split(m @ w_kv, 2, axis=-1)
    k = k.reshape(B, -1, MEM_HEADS, MEM_HEAD_DIM)
    v = v.reshape(B, -1, MEM_HEADS, MEM_HEAD_DIM)
    s = jnp.einsum('bqhd,bmhd->bhqm', q, k, preferred_element_type=jnp.float32) * (MEM_HEAD_DIM ** -0.5)
    p = jax.nn.softmax(s, axis=-1).astype(v.dtype)
    o = jnp.einsum('bhqm,bmhd->bqhd', p, v).reshape(B, S, D_MODEL)
    return o @ w_o


def setup_inputs(seed: int = 0) -> dict:
    key = jax.random.key(seed)
    ks = iter(jax.random.split(key, 40))

    def normal(shape, scale):
        return jax.random.normal(next(ks), shape, jnp.float32) * scale

    def gain(width):
        return 1.0 + normal((DEPTH, width), 0.02)

    L = DEPTH
    dt = jnp.exp(jax.random.uniform(next(ks), (L, GDN_HEADS), jnp.float32,
                                    minval=float(np.log(1e-3)), maxval=float(np.log(1e-1))))
    return {
        'x': normal((BATCH, SEQ, D_MODEL), 1.0),
        'mem': normal((BATCH, N_MEM, D_MODEL), 1.0),
        'ffn1_pre_norm': gain(D_MODEL),
        'ffn1_w_gate': normal((L, D_MODEL, D_FF), D_MODEL ** -0.5),
        'ffn1_w_up': normal((L, D_MODEL, D_FF), D_MODEL ** -0.5),
        'ffn1_w_down': normal((L, D_FF, D_MODEL), D_FF ** -0.5),
        'ffn1_post_norm': gain(D_MODEL),
        'mix_pre_norm': gain(D_MODEL),
        'w_in': normal((L, D_MODEL, IN_PROJ_WIDTH), D_MODEL ** -0.5),
        'fox_f_bias': jax.random.uniform(next(ks), (L, FOX_HEADS), jnp.float32, minval=1.0, maxval=4.0),
        'gdn_conv_w': normal((L, CONV_WIDTH, 3 * GDN_WIDTH), CONV_WIDTH ** -0.5),
        'gdn_a_log': jnp.log(jax.random.uniform(next(ks), (L, GDN_HEADS), jnp.float32, minval=1.0, maxval=16.0)),
        'gdn_dt_bias': dt + jnp.log(-jnp.expm1(-dt)),
        'gdn_out_norm': gain(GDN_HEAD_DIM),
        'w_out': normal((L, MIX_WIDTH, D_MODEL), MIX_WIDTH ** -0.5),
        'mix_post_norm': gain(D_MODEL),
        'mem_pre_norm': gain(D_MODEL),
        'mem_kv_norm': gain(D_MODEL),
        'mem_w_q': normal((L, D_MODEL, D_MODEL), D_MODEL ** -0.5),
        'mem_w_kv': normal((L, D_MODEL, 2 * D_MODEL), D_MODEL ** -0.5),
        'mem_w_o': normal((L, D_MODEL, D_MODEL), D_MODEL ** -0.5),
        'mem_post_norm': gain(D_MODEL),
        'ffn2_pre_norm': gain(D_MODEL),
        'ffn2_w_gate': normal((L, D_MODEL, D_FF), D_MODEL ** -0.5),
        'ffn2_w_up': normal((L, D_MODEL, D_FF), D_MODEL ** -0.5),
        'ffn2_w_down': normal((L, D_FF, D_MODEL), D_FF ** -0.5),
        'ffn2_post_norm': gain(D_MODEL),
    }


def reference(x, mem, ffn1_pre_norm, ffn1_w_gate, ffn1_w_up, ffn1_w_down, ffn1_post_norm,
              mix_pre_norm, w_in, fox_f_bias, gdn_conv_w, gdn_a_log, gdn_dt_bias, gdn_out_norm,
              w_out, mix_post_norm, mem_pre_norm, mem_kv_norm, mem_w_q, mem_w_kv, mem_w_o,
              mem_post_norm, ffn2_pre_norm, ffn2_w_gate, ffn2_w_up, ffn2_w_down, ffn2_post_norm):
    h = x
    for l in range(DEPTH):
        f = swiglu(rms_norm(h, ffn1_pre_norm[l]), ffn1_w_gate[l], ffn1_w_up[l], ffn1_w_down[l])
        h = h + FFN_RESIDUAL_WEIGHT * rms_norm(f, ffn1_post_norm[l])
        mixed = hybrid_mixer(rms_norm(h, mix_pre_norm[l]), w_in[l], fox_f_bias[l], gdn_conv_w[l],
                             gdn_a_log[l], gdn_dt_bias[l], gdn_out_norm[l])
        h = h + rms_norm(mixed @ w_out[l], mix_post_norm[l])
        c = memory_cross_attention(rms_norm(h, mem_pre_norm[l]), rms_norm(mem, mem_kv_norm[l]),
                                   mem_w_q[l], mem_w_kv[l], mem_w_o[l])
        h = h + rms_norm(c, mem_post_norm[l])
        f = swiglu(rms_norm(h, ffn2_pre_norm[l]), ffn2_w_gate[l], ffn2_w_up[l], ffn2_w_down[l])
        h = h + FFN_RESIDUAL_WEIGHT * rms_norm(f, ffn2_post_norm[l])
    return h
```

```cpp
#include <hip/hip_runtime.h>
#include <hip/hip_cooperative_groups.h>
#include <cstdio>
#include <cstdint>
namespace cg = cooperative_groups;

namespace pg8 {
#define PG8_LAS __attribute__((address_space(3)))
typedef unsigned short bf16_t;
typedef short bf16x8 __attribute__((ext_vector_type(8)));
typedef float f32x4 __attribute__((ext_vector_type(4)));
typedef unsigned u32x4 __attribute__((ext_vector_type(4)));
constexpr int BM = 256, BK = 64, HALF = 128, HTB = HALF * BK * 2  , STAGE_BYTES = 8 * HTB, NXCD = 8, WGM = 8;

__host__ __device__ __forceinline__ int lds_byte(int r, int c) { const int st = (r >> 4) * 2 + (c >> 5), rr = r & 15, cc = c & 31, ob = rr * 64 + cc * 2; return st * 1024 + (ob ^ (((ob >> 9) & 1) << 5)); }
__host__ __device__ __forceinline__ void stage_rc(int b, int& R, int& C) { const int st = b / 1024, sb = b % 1024, swz = sb ^ (((sb >> 9) & 1) << 5); R = (st >> 1) * 16 + swz / 64; C = (st & 1) * 32 + (swz % 64) / 2; }
__host__ __device__ __forceinline__ int perm32(int rho) { const int n = rho >> 4, i = rho & 15; return 8 * (i >> 2) + 4 * n + (i & 3); }

struct Unit { int pm, pn; };
struct Gemm { const bf16_t* A; const bf16_t* Bt; int M, N, K; };

struct StaticOrder {
    int nM, nN, nwg, G, c;
    __host__ __device__ void init(int M, int N, int G_, int c_) { nM = M / BM; nN = N / BM; nwg = nM * nN; G = G_; c = c_; }
    __host__ __device__ bool next(int i, Unit& u) const {
        const long L = (long)i * G + c; if (L >= nwg) return false;
        int wgid = (int)L; { const int q = nwg / NXCD, r = nwg % NXCD, xcd = wgid % NXCD, off = wgid / NXCD; wgid = (xcd < r ? xcd * (q + 1) : r * (q + 1) + (xcd - r) * q) + off; }
        const int nig = WGM * nN, gid = wgid / nig, fm = gid * WGM, gsz = (nM - fm) < WGM ? (nM - fm) : WGM;
        u.pm = fm + ((wgid % nig) % gsz); u.pn = (wgid % nig) / gsz; return true;
    }
    __device__ __forceinline__ void a_ready(const Unit&) const {}
    __device__ __forceinline__ void done(const Unit&) const {}
};

typedef float f32x2_t __attribute__((ext_vector_type(2))); typedef __bf16 bf16x2_t __attribute__((ext_vector_type(2)));
__device__ __forceinline__ unsigned cvt_pk_bf16(float lo, float hi) { f32x2_t v = {lo, hi}; bf16x2_t b = __builtin_convertvector(v, bf16x2_t); return __builtin_bit_cast(unsigned, b); }
struct EpiBf16 {
    static constexpr bool PERM = true, AFTER_DRAIN = false;
    bf16_t* O; int ldc; float scale;
    __device__ __forceinline__ void operator()(const f32x4 (&acc)[2][2][4][2], const Unit& u, int wr, int wc, int fr, int fq) const {
        const int row0 = u.pm * BM + wr * 64 + fr; const int col0 = u.pn * BM + wc * 32 + 8 * fq; const float sc = scale;
#pragma unroll
        for (int ai = 0; ai < 2; ++ai)
#pragma unroll
            for (int m = 0; m < 4; ++m) { bf16_t* rowp = O + (size_t)(row0 + ai * HALF + m * 16) * ldc + col0;
#pragma unroll
                for (int bj = 0; bj < 2; ++bj) { f32x4 v0 = acc[ai][bj][m][0] * sc, v1 = acc[ai][bj][m][1] * sc;
                    u32x4 w; w.x = cvt_pk_bf16(v0[0], v0[1]); w.y = cvt_pk_bf16(v0[2], v0[3]); w.z = cvt_pk_bf16(v1[0], v1[1]); w.w = cvt_pk_bf16(v1[2], v1[3]);
                    *(u32x4*)(rowp + bj * HALF) = w; } asm volatile("" ::: "memory"); }
    }
};
__device__ __forceinline__ float silu_f(float x) { return x * __builtin_amdgcn_rcpf(1.0f + __builtin_amdgcn_exp2f(-1.4426950408889634f * x)); }
struct EpiSwiGLU {
    static constexpr bool PERM = true, AFTER_DRAIN = false;
    bf16_t* O; int ldc;
    __device__ __forceinline__ void operator()(const f32x4 (&acc)[2][2][4][2], const Unit& u, int wr, int wc, int fr, int fq) const {
        const int row0 = u.pm * BM + wr * 64 + fr; const int col0 = u.pn * HALF + wc * 32 + 8 * fq;
#pragma unroll
        for (int ai = 0; ai < 2; ++ai)
#pragma unroll
            for (int m = 0; m < 4; ++m) { bf16_t* rowp = O + (size_t)(row0 + ai * HALF + m * 16) * ldc + col0;
                const f32x4 g0 = acc[ai][0][m][0], g1 = acc[ai][0][m][1], u0 = acc[ai][1][m][0], u1 = acc[ai][1][m][1];
                float h[8];
#pragma unroll
                for (int e = 0; e < 4; ++e) { h[e] = silu_f(g0[e]) * u0[e]; h[4 + e] = silu_f(g1[e]) * u1[e]; }
                u32x4 w; w.x = cvt_pk_bf16(h[0], h[1]); w.y = cvt_pk_bf16(h[2], h[3]); w.z = cvt_pk_bf16(h[4], h[5]); w.w = cvt_pk_bf16(h[6], h[7]);
                *(u32x4*)rowp = w; asm volatile("" ::: "memory"); }
    }
};
struct EpiProj {
    static constexpr bool PERM = true, AFTER_DRAIN = false;
    bf16_t* PJ; float* SM; float qscale;
    __device__ __forceinline__ void operator()(const f32x4 (&acc)[2][2][4][2], const Unit& u, int wr, int wc, int fr, int fq) const {
        const int row0 = u.pm * BM + wr * 64 + fr;
        if (u.pn < 12) {
            const int col0 = u.pn * BM + wc * 32 + 8 * fq; const float sc = (u.pn < 2) ? qscale : 1.0f;
#pragma unroll
            for (int ai = 0; ai < 2; ++ai)
#pragma unroll
                for (int m = 0; m < 4; ++m) { bf16_t* rowp = PJ + (size_t)(row0 + ai * HALF + m * 16) * 3072 + col0;
#pragma unroll
                    for (int bj = 0; bj < 2; ++bj) { f32x4 v0 = acc[ai][bj][m][0] * sc, v1 = acc[ai][bj][m][1] * sc;
                        u32x4 w; w.x = cvt_pk_bf16(v0[0], v0[1]); w.y = cvt_pk_bf16(v0[2], v0[3]); w.z = cvt_pk_bf16(v1[0], v1[1]); w.w = cvt_pk_bf16(v1[2], v1[3]);
                        *(u32x4*)(rowp + bj * HALF) = w; } asm volatile("" ::: "memory"); }
        } else if (wc == 0 && fq < 2) {
#pragma unroll
            for (int ai = 0; ai < 2; ++ai)
#pragma unroll
                for (int m = 0; m < 4; ++m) { float* rowp = SM + (size_t)(row0 + ai * HALF + m * 16) * 16 + 8 * fq;
                    *(f32x4*)rowp = acc[ai][0][m][0]; *(f32x4*)(rowp + 4) = acc[ai][0][m][1]; }
        }
    }
};
template <class Epi, class Sched, bool ALIGN_EPI = false, bool SP2 = false>
__device__ __forceinline__ void gemm_phase(PG8_LAS unsigned char* lds, const Gemm g, const Sched& S, const Epi& E) {
    int tid_l = threadIdx.x; asm volatile("" : "+v"(tid_l));
    const int tid = tid_l, wid = __builtin_amdgcn_readfirstlane(tid >> 6), lane = tid & 63, wr = wid >> 2, wc = wid & 3, fr = lane & 15, fq = lane >> 4;
    const int K = g.K, nt = K / BK;
    unsigned voffA[2], voffB[2];
#pragma unroll
    for (int i = 0; i < 2; ++i) { int R, C; stage_rc(tid * 16 + i * 8192, R, C); const int Rb = Epi::PERM ? ((R & ~31) + perm32(R & 31)) : R;
        voffA[i] = (unsigned)(R * K + C) * 2u; voffB[i] = (unsigned)(Rb * K + C) * 2u; }
    const size_t kstep = (size_t)(BK * 2);
    const size_t hstep = (size_t)HALF * K * 2;
    const size_t tstep = 2 * hstep;
    const unsigned ldsw = (unsigned)wid * 1024u;
    const int aoff = lds_byte(wr * 64 + fr, fq * 8), boff = lds_byte(wc * 32 + fr, fq * 8);
#define PG8_SA(b, h) (((b) * 2 + (h)) * HTB)
#define PG8_SB(b, h) ((4 + (b) * 2 + (h)) * HTB)
#define PG8_STAGE(bufoff, gbase, voff) do { _Pragma("unroll") for (int _i = 0; _i < 2; ++_i) \
        __builtin_amdgcn_global_load_lds((const unsigned*)((const char*)(gbase) + (voff)[_i]), (PG8_LAS unsigned*)(lds + (bufoff) + ldsw + _i * 8192), 16, 0, 0); } while (0)
#define PG8_LDA(dst, b, h) do { _Pragma("unroll") for (int m = 0; m < 4; ++m) _Pragma("unroll") for (int k = 0; k < 2; ++k) dst[m][k] = *(const PG8_LAS bf16x8*)(lds + PG8_SA(b, h) + aoff + m * 2048 + k * 1024); } while (0)
#define PG8_LDB(dst, b, h) do { _Pragma("unroll") for (int n = 0; n < 2; ++n) _Pragma("unroll") for (int k = 0; k < 2; ++k) dst[n][k] = *(const PG8_LAS bf16x8*)(lds + PG8_SB(b, h) + boff + n * 2048 + k * 1024); } while (0)
#define PG8_MMA(ai, bj, At, Bt) do { __builtin_amdgcn_s_setprio(1); _Pragma("unroll") for (int m = 0; m < 4; ++m) _Pragma("unroll") for (int n = 0; n < 2; ++n) _Pragma("unroll") for (int k = 0; k < 2; ++k) \
        acc[ai][bj][m][n] = __builtin_amdgcn_mfma_f32_16x16x32_bf16(Bt[n][k], At[m][k], acc[ai][bj][m][n], 0, 0, 0); __builtin_amdgcn_s_setprio(0); } while (0)
#define PG8_WAIT_V(n) asm volatile("s_waitcnt vmcnt(" #n ")" ::: "memory")
#define PG8_WAIT_L(n) asm volatile("s_waitcnt lgkmcnt(" #n ")" ::: "memory")
#define PG8_BAR __builtin_amdgcn_s_barrier()
#define PG8_SCHED __builtin_amdgcn_sched_barrier(0)
    Unit cur, nxt; int ui = 0;
    if (!S.next(0, cur)) return;
    f32x4 acc[2][2][4][2];
#pragma unroll
    for (int a = 0; a < 2; ++a)
#pragma unroll
        for (int b = 0; b < 2; ++b)
#pragma unroll
            for (int m = 0; m < 4; ++m)
#pragma unroll
                for (int n = 0; n < 2; ++n) acc[a][b][m][n] = (f32x4){0.f, 0.f, 0.f, 0.f};
    bf16x8 At[4][2], B0[2][2], B1[2][2];
    const char* cA = (const char*)g.A + (size_t)cur.pm * tstep; const char* cB = (const char*)g.Bt + (size_t)cur.pn * tstep;
    S.a_ready(cur);
    if constexpr (SP2) {
        PG8_STAGE(PG8_SB(0, 0), cB, voffB); PG8_STAGE(PG8_SB(0, 1), cB + hstep, voffB); PG8_STAGE(PG8_SA(0, 0), cA, voffA); PG8_STAGE(PG8_SA(0, 1), cA + hstep, voffA);
        if (wr == 1) PG8_BAR;
        PG8_WAIT_V(2); PG8_BAR;
        PG8_STAGE(PG8_SB(1, 0), cB + kstep, voffB); PG8_STAGE(PG8_SA(1, 0), cA + kstep, voffA); PG8_STAGE(PG8_SB(1, 1), cB + hstep + kstep, voffB);
        PG8_WAIT_V(6); PG8_BAR;
    } else {
        PG8_STAGE(PG8_SB(0, 0), cB, voffB); PG8_STAGE(PG8_SA(0, 0), cA, voffA); PG8_STAGE(PG8_SB(0, 1), cB + hstep, voffB); PG8_STAGE(PG8_SA(0, 1), cA + hstep, voffA);
        if (wr == 1) PG8_BAR;
        PG8_WAIT_V(4); PG8_BAR;
        PG8_STAGE(PG8_SB(1, 0), cB + kstep, voffB); PG8_STAGE(PG8_SA(1, 0), cA + kstep, voffA); PG8_STAGE(PG8_SB(1, 1), cB + hstep + kstep, voffB);
        PG8_WAIT_V(6); PG8_BAR;
    }
    for (;;) {
        const bool has_next = S.next(ui + 1, nxt);
        const char* nA = has_next ? (const char*)g.A + (size_t)nxt.pm * tstep : cA; const char* nB = has_next ? (const char*)g.Bt + (size_t)nxt.pn * tstep : cB;
        for (int t = 0; t < nt; t += 2) {
            const bool last = (t == nt - 2);
            const char* a1 = cA + (size_t)(t + 1) * kstep;
            const char* a2 = last ? nA : cA + (size_t)(t + 2) * kstep; const char* b2 = last ? nB : cB + (size_t)(t + 2) * kstep;
            const char* a3 = a2 + kstep; const char* b3 = b2 + kstep;
            if (last && has_next) S.a_ready(nxt);
            if constexpr (SP2) {
            PG8_LDB(B0, 0, 0); PG8_LDB(B1, 0, 1); PG8_SCHED; PG8_LDA(At, 0, 0); PG8_STAGE(PG8_SA(1, 1), a1 + hstep, voffA);
            PG8_WAIT_V(8); PG8_WAIT_L(0); PG8_BAR; PG8_MMA(0, 0, At, B0); PG8_MMA(0, 1, At, B1); PG8_BAR; PG8_SCHED;
            PG8_LDA(At, 0, 1); PG8_STAGE(PG8_SB(0, 0), b2, voffB); PG8_STAGE(PG8_SB(0, 1), b2 + hstep, voffB); PG8_STAGE(PG8_SA(0, 0), a2, voffA);
            PG8_WAIT_V(8); PG8_WAIT_L(0); PG8_BAR; PG8_MMA(1, 0, At, B0); PG8_MMA(1, 1, At, B1); PG8_BAR; PG8_SCHED;
            PG8_LDB(B0, 1, 0); PG8_LDB(B1, 1, 1); PG8_SCHED; PG8_LDA(At, 1, 0); PG8_STAGE(PG8_SA(0, 1), a2 + hstep, voffA);
            PG8_WAIT_V(8); PG8_WAIT_L(0); PG8_BAR; PG8_MMA(0, 0, At, B0); PG8_MMA(0, 1, At, B1); PG8_BAR; PG8_SCHED;
            PG8_LDA(At, 1, 1); PG8_STAGE(PG8_SB(1, 0), b3, voffB); PG8_STAGE(PG8_SB(1, 1), b3 + hstep, voffB); PG8_STAGE(PG8_SA(1, 0), a3, voffA);
            PG8_WAIT_V(8); PG8_WAIT_L(0); PG8_BAR; PG8_MMA(1, 0, At, B0); PG8_MMA(1, 1, At, B1); PG8_BAR; PG8_SCHED;
            } else {
            PG8_LDB(B0, 0, 0); PG8_SCHED; PG8_LDA(At, 0, 0); PG8_STAGE(PG8_SA(1, 1), a1 + hstep, voffA);
            PG8_WAIT_L(8); PG8_BAR; PG8_WAIT_L(0); PG8_MMA(0, 0, At, B0); PG8_BAR; PG8_SCHED;
            PG8_LDB(B1, 0, 1); PG8_STAGE(PG8_SB(0, 0), b2, voffB);
            PG8_BAR; PG8_WAIT_L(0); PG8_MMA(0, 1, At, B1); PG8_BAR;
            PG8_LDA(At, 0, 1); PG8_STAGE(PG8_SA(0, 0), a2, voffA);
            PG8_BAR; PG8_WAIT_L(0); PG8_MMA(1, 0, At, B0); PG8_BAR; PG8_SCHED;
            PG8_STAGE(PG8_SB(0, 1), b2 + hstep, voffB);
            PG8_WAIT_V(6); PG8_BAR; PG8_MMA(1, 1, At, B1); PG8_BAR;
            PG8_LDB(B0, 1, 0); PG8_SCHED; PG8_LDA(At, 1, 0); PG8_STAGE(PG8_SA(0, 1), a2 + hstep, voffA);
            PG8_WAIT_L(8); PG8_BAR; PG8_WAIT_L(0); PG8_MMA(0, 0, At, B0); PG8_BAR; PG8_SCHED;
            PG8_LDB(B1, 1, 1); PG8_STAGE(PG8_SB(1, 0), b3, voffB);
            PG8_BAR; PG8_WAIT_L(0); PG8_MMA(0, 1, At, B1); PG8_BAR;
            PG8_LDA(At, 1, 1); PG8_STAGE(PG8_SA(1, 0), a3, voffA);
            PG8_BAR; PG8_WAIT_L(0); PG8_MMA(1, 0, At, B0); PG8_BAR; PG8_SCHED;
            PG8_STAGE(PG8_SB(1, 1), b3 + hstep, voffB);
            PG8_WAIT_V(6); PG8_BAR; PG8_MMA(1, 1, At, B1); PG8_BAR;
            }
        }
        if constexpr (ALIGN_EPI) { if (wr == 0) PG8_BAR; }
        if constexpr (!Epi::AFTER_DRAIN) { E(acc, cur, wr, wc, fr, fq); S.done(cur); }
        if (!has_next) break;
#pragma unroll
        for (int a = 0; a < 2; ++a)
#pragma unroll
            for (int b = 0; b < 2; ++b)
#pragma unroll
                for (int m = 0; m < 4; ++m)
#pragma unroll
                    for (int n = 0; n < 2; ++n) acc[a][b][m][n] = (f32x4){0.f, 0.f, 0.f, 0.f};
        cur = nxt; cA = nA; cB = nB; ++ui;
        if constexpr (ALIGN_EPI) { if (wr == 1) PG8_BAR; }
    }
    PG8_WAIT_V(0);
    if constexpr (!ALIGN_EPI) { if (wr == 0) PG8_BAR; }
    PG8_BAR;
    if constexpr (Epi::AFTER_DRAIN) { E.fused(acc, cur, wr, wc, fr, fq, lds, wid, lane); S.done(cur); }
#undef PG8_SA
#undef PG8_SB
#undef PG8_STAGE
#undef PG8_LDA
#undef PG8_LDB
#undef PG8_MMA
#undef PG8_WAIT_V
#undef PG8_WAIT_L
#undef PG8_BAR
#undef PG8_SCHED
}
}
#define LAS __attribute__((address_space(3)))
typedef unsigned short bf16_t;
typedef short bf16x8 __attribute__((ext_vector_type(8)));
typedef float f32x4 __attribute__((ext_vector_type(4)));
typedef unsigned u32x4 __attribute__((ext_vector_type(4)));
typedef unsigned u32x2 __attribute__((ext_vector_type(2)));
using pg8::cvt_pk_bf16;
constexpr int SEQ = 8192, NB = 8, MTOK = NB * SEQ, DM = 1024, DFF = 2816, NMEM = 256;
constexpr float EPSN = 1e-6f, LOG2E = 1.4426950408889634f;
constexpr float FOX_QSCALE = 0.125f * LOG2E;
constexpr float MEM_QSCALE = 0.0625f * LOG2E;
constexpr float FOX_T2 = 60.0f;
constexpr size_t MiB = 1u << 20;
constexpr size_t WS_CTL = 0, CTL_BYTES = 32768;
constexpr size_t WS_SM = 2 * MiB, WS_FC = 6 * MiB, WS_KMEM = 8 * MiB, WS_VMEMT = 12 * MiB, WS_AMEM = 16 * MiB, WS_MISC = 20 * MiB;
constexpr size_t WS_WGU1 = 24 * MiB, WS_WD1 = 35 * MiB, WS_WIN = 41 * MiB, WS_WVT = 48 * MiB, WS_WOUT = 49 * MiB, WS_WQ = 51 * MiB, WS_WKV = 53 * MiB, WS_WO = 57 * MiB, WS_WGU2 = 59 * MiB, WS_WD2 = 70 * MiB;
constexpr size_t WS_A = 80 * MiB, WS_F = 208 * MiB, WS_BIG = 336 * MiB, WS_VT = 720 * MiB, WS_UT = 784 * MiB, WS_KTT = 848 * MiB, WS_ATT = 912 * MiB, WS_END = 944 * MiB;
constexpr size_t WS_NW = WS_F, WS_QD = WS_F + 64 * MiB;
constexpr size_t MISC_KT0 = 0, MISC_EGL = 65536;
constexpr int LDS_BYTES = 151552;
constexpr int LDS_BCAST = 150000;

struct Params { const float* in[27]; float* out; unsigned char* ws; };

__device__ __forceinline__ float bf2f(unsigned short b) { return __uint_as_float((unsigned)b << 16); }
__device__ __forceinline__ float bflo(unsigned w) { return __uint_as_float(w << 16); }
__device__ __forceinline__ float bfhi(unsigned w) { return __uint_as_float(w & 0xffff0000u); }
__device__ __forceinline__ float wave_sum(float v) {
#pragma unroll
    for (int o = 1; o < 64; o <<= 1) v += __shfl_xor(v, o);
    return v;
}
__device__ __forceinline__ float softplus_f(float x) { return fmaxf(x, 0.f) + log1pf(__expf(-fabsf(x))); }
#define LDS_WAIT() asm volatile("s_waitcnt lgkmcnt(0)" ::: "memory")

struct MapIdent { int off; __device__ __forceinline__ int operator()(int n) const { return n + off; } };
struct MapGate { __device__ __forceinline__ int operator()(int n) const { return (n >> 7) * 256 + (n & 127); } };
struct MapUp { __device__ __forceinline__ int operator()(int n) const { return (n >> 7) * 256 + 128 + (n & 127); } };
struct MapWin { __device__ __forceinline__ int operator()(int n) const {
    if (n < 1024) return n; if (n < 1536) return -1; if (n < 1544) return 3072 + (n - 1536); if (n < 3592) return 1024 + (n - 1544); return 3080 + (n - 3592); } };
struct MapWinV { __device__ __forceinline__ int operator()(int n) const { return (n >= 1024 && n < 1536) ? n - 1024 : -1; } };

template <class Map> __device__ __forceinline__ void transpose_item(const float* W, int K, int N, bf16_t* WT, const Map map, LAS float* scr, int item, int lane) {
    const int nblk = (N + 31) >> 5, kb = item / nblk, nb = item - kb * nblk, k0 = 64 * kb, n0 = 32 * nb;
    const int nn = n0 + (lane & 31);
#pragma unroll 8
    for (int i = 0; i < 32; ++i) { const int kk = 2 * i + (lane >> 5); scr[kk * 33 + (lane & 31)] = (nn < N) ? W[(size_t)(k0 + kk) * N + nn] : 0.f; }
    LDS_WAIT(); asm volatile("" ::: "memory");
    const int c = lane & 7;
#pragma unroll
    for (int j = 0; j < 4; ++j) { const int nl = (lane >> 3) + 8 * j; const int n = n0 + nl; const LAS float* s = scr + (8 * c) * 33 + nl;
        if (n < N) { const int dr = map(n);
            if (dr >= 0) { u32x4 o; o.x = cvt_pk_bf16(s[0 * 33], s[1 * 33]); o.y = cvt_pk_bf16(s[2 * 33], s[3 * 33]); o.z = cvt_pk_bf16(s[4 * 33], s[5 * 33]); o.w = cvt_pk_bf16(s[6 * 33], s[7 * 33]);
                *(u32x4*)(WT + (size_t)dr * K + k0 + 8 * c) = o; } } }
    LDS_WAIT(); asm volatile("" ::: "memory");
}
template <class Map> __device__ __forceinline__ void transpose_all(const float* W, int K, int N, bf16_t* WT, const Map map, LAS float* scr, int gw, int ngw, int lane) {
    const int nitems = (K / 64) * ((N + 31) >> 5);
    for (int it = gw; it < nitems; it += ngw) transpose_item(W, K, N, WT, map, scr, it, lane);
}

__device__ __forceinline__ void row_phase(const float* hin, const bf16_t* Fb, const float* gpost, float wres, float* hout, const float* gnext, bf16_t* Aout, int nrows, int gw, int ngw, int lane) {
    f32x4 gp[4], gn[4];
#pragma unroll
    for (int j = 0; j < 4; ++j) { gp[j] = Fb ? ((const f32x4*)gpost)[lane + 64 * j] : (f32x4){0.f, 0.f, 0.f, 0.f}; gn[j] = Aout ? ((const f32x4*)gnext)[lane + 64 * j] : (f32x4){0.f, 0.f, 0.f, 0.f}; }
    for (int r = gw; r < nrows; r += ngw) {
        f32x4 v[4];
#pragma unroll
        for (int j = 0; j < 4; ++j) v[j] = ((const f32x4*)(hin + (size_t)r * DM))[lane + 64 * j];
        if (Fb) {
            f32x4 f[4]; float ss = 0.f;
#pragma unroll
            for (int j = 0; j < 4; ++j) { const u32x2 w = ((const u32x2*)(Fb + (size_t)r * DM))[lane + 64 * j];
                f[j] = (f32x4){bflo(w.x), bfhi(w.x), bflo(w.y), bfhi(w.y)}; ss += (f[j].x * f[j].x + f[j].y * f[j].y) + (f[j].z * f[j].z + f[j].w * f[j].w); }
            const float rs = wres * rsqrtf(wave_sum(ss) * (1.f / DM) + EPSN);
#pragma unroll
            for (int j = 0; j < 4; ++j) v[j] = v[j] + (f[j] * rs) * gp[j];
        }
        if (hout) {
#if defined(SANITIZE)
#pragma unroll
            for (int j = 0; j < 4; ++j)
#pragma unroll
                for (int e = 0; e < 4; ++e) if (!(fabsf(v[j][e]) < 1e30f)) v[j][e] = 1e4f;
#endif
#pragma unroll
            for (int j = 0; j < 4; ++j) ((f32x4*)(hout + (size_t)r * DM))[lane + 64 * j] = v[j];
        }
        if (Aout) {
            float ss = 0.f;
#pragma unroll
            for (int j = 0; j < 4; ++j) ss += (v[j].x * v[j].x + v[j].y * v[j].y) + (v[j].z * v[j].z + v[j].w * v[j].w);
            const float rs = rsqrtf(wave_sum(ss) * (1.f / DM) + EPSN);
#pragma unroll
            for (int j = 0; j < 4; ++j) { const f32x4 o = (v[j] * rs) * gn[j]; u32x2 w; w.x = cvt_pk_bf16(o.x, o.y); w.y = cvt_pk_bf16(o.z, o.w);
                ((u32x2*)(Aout + (size_t)r * DM))[lane + 64 * j] = w; }
        }
    }
}

template <int D, bool FOX>
__device__ __forceinline__ void attn_unit(LAS unsigned char* lds, const bf16_t* Q, int ldq, const bf16_t* K, int ldk, const bf16_t* VT, int ldvt, bf16_t* O, int ldo,
                                          const float* Fc, int qb, int kt0, int kt1, int tid, int wid, int lane) {
    constexpr int KP = D + 8, VP = 72, NP = D / 64, KS = D / 32, DJ = D / 16;
    LAS bf16_t* Kl = (LAS bf16_t*)lds; LAS bf16_t* Vl = (LAS bf16_t*)(lds + 64 * KP * 2); LAS float* Fk = (LAS float*)(lds + 64 * KP * 2 + D * VP * 2);
    const int fr = lane & 15, fq = lane >> 4;
    const int q0 = qb * 128 + wid * 16;
    bf16x8 qf[KS];
#pragma unroll
    for (int ks = 0; ks < KS; ++ks) qf[ks] = *(const bf16x8*)(Q + (size_t)(q0 + fr) * ldq + 32 * ks + 8 * fq);
    float Fq = 0.f; if (FOX) Fq = Fc[q0 + fr];
    f32x4 o[DJ];
#pragma unroll
    for (int dj = 0; dj < DJ; ++dj) o[dj] = (f32x4){0.f, 0.f, 0.f, 0.f};
    float mrun = -INFINITY, lrun = 0.f;
    u32x4 kreg[NP], vreg[NP]; float fkreg = 0.f;
#define ATT_GLOAD(kt) do { _Pragma("unroll") for (int i_ = 0; i_ < NP; ++i_) { const int p_ = tid + 512 * i_; \
        { const int row_ = p_ / (D / 8), c_ = p_ % (D / 8); kreg[i_] = *(const u32x4*)(K + (size_t)((kt) * 64 + row_) * ldk + c_ * 8); } \
        { const int row_ = p_ >> 3, c_ = p_ & 7; vreg[i_] = *(const u32x4*)(VT + (size_t)row_ * ldvt + (kt) * 64 + c_ * 8); } } \
        if (FOX && tid < 64) fkreg = Fc[(kt) * 64 + tid]; } while (0)
    constexpr bool PREF = (D == 64);
    if (PREF) ATT_GLOAD(kt0);
    for (int kt = kt0; kt <= kt1; ++kt) {
        if (!PREF) ATT_GLOAD(kt);
        __syncthreads();
#pragma unroll
        for (int i = 0; i < NP; ++i) { const int p = tid + 512 * i;
            { const int row = p / (D / 8), c = p % (D / 8); *(LAS u32x4*)(Kl + row * KP + c * 8) = kreg[i]; }
            { const int row = p >> 3, c = p & 7; *(LAS u32x4*)(Vl + row * VP + c * 8) = vreg[i]; } }
        if (FOX && tid < 64) Fk[tid] = fkreg;
        __syncthreads();
        if (PREF && kt < kt1) ATT_GLOAD(kt + 1);
        if (FOX && kt * 64 > q0 + 15) continue;
        f32x4 s[4];
#pragma unroll
        for (int j = 0; j < 4; ++j) { if (FOX) { const f32x4 fk4 = *(const LAS f32x4*)(Fk + 16 * j + 4 * fq); s[j] = Fq - fk4; } else s[j] = (f32x4){0.f, 0.f, 0.f, 0.f}; }
#pragma unroll
        for (int ks = 0; ks < KS; ++ks)
#pragma unroll
            for (int j = 0; j < 4; ++j) { const bf16x8 kf = *(const LAS bf16x8*)(Kl + (16 * j + fr) * KP + 32 * ks + 8 * fq);
                s[j] = __builtin_amdgcn_mfma_f32_16x16x32_bf16(kf, qf[ks], s[j], 0, 0, 0); }
        if (FOX && kt * 64 + 63 > q0) {
#pragma unroll
            for (int j = 0; j < 4; ++j)
#pragma unroll
                for (int r = 0; r < 4; ++r) { const int key = kt * 64 + 16 * j + 4 * fq + r; if (key > q0 + fr) s[j][r] = -INFINITY; }
        }
        float mx = fmaxf(fmaxf(s[0][0], s[0][1]), fmaxf(s[0][2], s[0][3]));
#pragma unroll
        for (int j = 1; j < 4; ++j) mx = fmaxf(mx, fmaxf(fmaxf(s[j][0], s[j][1]), fmaxf(s[j][2], s[j][3])));
        mx = fmaxf(mx, __shfl_xor(mx, 16)); mx = fmaxf(mx, __shfl_xor(mx, 32));
        const float mnew = fmaxf(mrun, mx);
        const float alpha = __builtin_amdgcn_exp2f(mrun - mnew);
        mrun = mnew;
        float ls = 0.f;
#pragma unroll
        for (int j = 0; j < 4; ++j)
#pragma unroll
            for (int r = 0; r < 4; ++r) { s[j][r] = __builtin_amdgcn_exp2f(s[j][r] - mnew); ls += s[j][r]; }
        lrun = lrun * alpha + ls;
#pragma unroll
        for (int dj = 0; dj < DJ; ++dj) o[dj] = o[dj] * alpha;
        bf16x8 pf[2];
#pragma unroll
        for (int k2 = 0; k2 < 2; ++k2) { u32x4 w; w.x = cvt_pk_bf16(s[2 * k2][0], s[2 * k2][1]); w.y = cvt_pk_bf16(s[2 * k2][2], s[2 * k2][3]);
            w.z = cvt_pk_bf16(s[2 * k2 + 1][0], s[2 * k2 + 1][1]); w.w = cvt_pk_bf16(s[2 * k2 + 1][2], s[2 * k2 + 1][3]); pf[k2] = __builtin_bit_cast(bf16x8, w); }
#pragma unroll
        for (int dj = 0; dj < DJ; ++dj)
#pragma unroll
            for (int k2 = 0; k2 < 2; ++k2) { const u32x2 lo = *(const LAS u32x2*)(Vl + (16 * dj + fr) * VP + 32 * k2 + 4 * fq), hi = *(const LAS u32x2*)(Vl + (16 * dj + fr) * VP + 32 * k2 + 16 + 4 * fq);
                const u32x4 w = (u32x4){lo.x, lo.y, hi.x, hi.y};
                o[dj] = __builtin_amdgcn_mfma_f32_16x16x32_bf16(__builtin_bit_cast(bf16x8, w), pf[k2], o[dj], 0, 0, 0); }
    }
#undef ATT_GLOAD
    lrun += __shfl_xor(lrun, 16); lrun += __shfl_xor(lrun, 32);
    const float inv = 1.0f / lrun;
#pragma unroll
    for (int dj = 0; dj < DJ; ++dj) { u32x2 w; w.x = cvt_pk_bf16(o[dj][0] * inv, o[dj][1] * inv); w.y = cvt_pk_bf16(o[dj][2] * inv, o[dj][3] * inv);
        *(u32x2*)(O + (size_t)(q0 + fr) * ldo + 16 * dj + 4 * fq) = w; }
    __syncthreads();
}

__device__ __forceinline__ void fox_prep(LAS unsigned char* lds, const Params& P, int bh, int tid, int wid, int lane) {
    LAS float* WS = (LAS float*)lds;
    LAS float* E = WS + 16;
    LAS float* F0 = E + 128;
    LAS unsigned* MX = (LAS unsigned*)(F0 + 64);
    const int b = bh >> 3, h = bh & 7;
    const float* SM = (const float*)(P.ws + WS_SM); float* FC = (float*)(P.ws + WS_FC) + (size_t)bh * SEQ;
    const bf16_t* PJ = (const bf16_t*)(P.ws + WS_BIG);
    const float bias = P.in[9][h];
    if (tid < 2) MX[tid] = 0u;
    float pre[16]; float run = 0.f;
#pragma unroll
    for (int i = 0; i < 16; ++i) { const float x = SM[(size_t)(b * SEQ + 16 * tid + i) * 16 + h] + bias; const float ls = -softplus_f(-x) * LOG2E; run += ls; pre[i] = run; }
    float sc = run;
#pragma unroll
    for (int off = 1; off < 64; off <<= 1) { const float v = __shfl_up(sc, off); if (lane >= off) sc += v; }
    if (lane == 63) WS[wid] = sc;
    __syncthreads();
    float base = sc - run;
    for (int w = 0; w < wid; ++w) base += WS[w];
#pragma unroll
    for (int i = 0; i < 16; ++i) { pre[i] += base; FC[16 * tid + i] = pre[i]; }
    if ((tid & 3) == 3) E[tid >> 2] = pre[15];
    if ((tid & 7) == 0) F0[tid >> 3] = pre[0];
    float mq = 0.f, mk = 0.f;
    for (int i = 0; i < 16; ++i) { const bf16_t* qrow = PJ + (size_t)(b * SEQ + 16 * tid + i) * 3072 + h * 64; float sq = 0.f, sk = 0.f;
#pragma unroll
        for (int c = 0; c < 8; ++c) { const u32x4 a = *(const u32x4*)(qrow + 8 * c), k4 = *(const u32x4*)(qrow + 512 + 8 * c);
#pragma unroll
            for (int e = 0; e < 4; ++e) { const float a0 = bflo(a[e]), a1 = bfhi(a[e]), k0 = bflo(k4[e]), k1 = bfhi(k4[e]); sq += a0 * a0 + a1 * a1; sk += k0 * k0 + k1 * k1; } }
        mq = fmaxf(mq, sq); mk = fmaxf(mk, sk); }
    atomicMax((unsigned*)MX, __float_as_uint(mq)); atomicMax((unsigned*)MX + 1, __float_as_uint(mk));
    __syncthreads();
    if (tid < 64) { const float bound = 2.0f * sqrtf(__uint_as_float(MX[0]) * __uint_as_float(MX[1])) * 1.01f + 1.0f;
        const float f0 = F0[tid]; int kt = 0; while (kt < 2 * tid && f0 - E[kt] + bound < -FOX_T2) ++kt;
        ((int*)(P.ws + WS_MISC + MISC_KT0))[bh * 64 + tid] = kt; }
    __syncthreads();
}

constexpr int GP_KL = 0, GP_QL = 17408, GP_RHS = 34816, RHSP = 260, GP_LL = GP_RHS + 64 * RHSP * 4, GP_GC = GP_LL + 16384, GP_BETA = GP_GC + 256;
__device__ __forceinline__ void gdn_prep_chunk(LAS unsigned char* lds, const Params& P, int ci, int tid, int wid, int lane) {
    LAS bf16_t* Kl = (LAS bf16_t*)(lds + GP_KL); LAS bf16_t* Ql = (LAS bf16_t*)(lds + GP_QL); LAS float* RHS = (LAS float*)(lds + GP_RHS); LAS float* Ll = (LAS float*)(lds + GP_LL);
    LAS float* GC = (LAS float*)(lds + GP_GC); LAS float* BETA = (LAS float*)(lds + GP_BETA);
    const int b = ci >> 9, h = (ci >> 7) & 3, c = ci & 127;
    const float* SM = (const float*)(P.ws + WS_SM); const bf16_t* PJ = (const bf16_t*)(P.ws + WS_BIG);
    bf16_t* NW = (bf16_t*)(P.ws + WS_NW) + (size_t)ci * 8192; bf16_t* QD = (bf16_t*)(P.ws + WS_QD) + (size_t)ci * 8192; bf16_t* ATT = (bf16_t*)(P.ws + WS_ATT) + (size_t)ci * 4096;
    bf16_t* KTT = (bf16_t*)(P.ws + WS_KTT) + (size_t)ci * 8192; bf16_t* UT = (bf16_t*)(P.ws + WS_UT) + (size_t)ci * 8192;
    const size_t R0 = (size_t)b * SEQ + (size_t)c * 64;
    if (wid == 0) {
        const float ga = SM[(R0 + lane) * 16 + 12 + h], gb = SM[(R0 + lane) * 16 + 8 + h];
        float g = -__expf(P.in[11][h]) * softplus_f(ga + P.in[12][h]);
#pragma unroll
        for (int off = 1; off < 64; off <<= 1) { const float v = __shfl_up(g, off); if (lane >= off) g += v; }
        GC[lane] = g; BETA[lane] = 1.0f / (1.0f + __expf(-gb));
        if (lane == 63) ((float*)(P.ws + WS_MISC + MISC_EGL))[ci] = __expf(g);
    }
    __syncthreads();
    {
        const int t = tid >> 3, cg8 = tid & 7, ch0 = 16 * cg8; const int tseq = c * 64 + t;
        float y[3][16];
#pragma unroll
        for (int mat = 0; mat < 3; ++mat) {
#pragma unroll
            for (int e = 0; e < 16; ++e) y[mat][e] = 0.f;
#pragma unroll
            for (int i = 0; i < 4; ++i) { const int tt = tseq - 3 + i;
                if (tt >= 0) { const bf16_t* src = PJ + ((size_t)b * SEQ + tt) * 3072 + 1024 + 512 * mat + h * 128 + ch0; const float* wsrc = P.in[10] + i * 1536 + 512 * mat + h * 128 + ch0;
                    const u32x4 x0 = *(const u32x4*)src, x1 = *(const u32x4*)(src + 8);
#pragma unroll
                    for (int e = 0; e < 4; ++e) { const f32x4 w4 = *(const f32x4*)(wsrc + 4 * e); const unsigned xa = (e < 2) ? x0[2 * e] : x1[2 * e - 4], xb = (e < 2) ? x0[2 * e + 1] : x1[2 * e - 3];
                        y[mat][4 * e + 0] += w4.x * bflo(xa); y[mat][4 * e + 1] += w4.y * bfhi(xa); y[mat][4 * e + 2] += w4.z * bflo(xb); y[mat][4 * e + 3] += w4.w * bfhi(xb); } } }
#pragma unroll
            for (int e = 0; e < 16; ++e) y[mat][e] = pg8::silu_f(y[mat][e]);
        }
        float sq = 0.f, sk = 0.f;
#pragma unroll
        for (int e = 0; e < 16; ++e) { sq += y[0][e] * y[0][e]; sk += y[1][e] * y[1][e]; }
#pragma unroll
        for (int o = 1; o < 8; o <<= 1) { sq += __shfl_xor(sq, o); sk += __shfl_xor(sk, o); }
        const float rq = rsqrtf(sq + EPSN) * 0.08838834764831845f, rk = rsqrtf(sk + EPSN);
        const float gct = GC[t], bt = BETA[t], egt = __expf(gct);
#pragma unroll
        for (int e = 0; e < 16; ++e) { y[0][e] *= rq; y[1][e] *= rk; }
        u32x4 w0, w1;
        w0.x = cvt_pk_bf16(y[1][0], y[1][1]); w0.y = cvt_pk_bf16(y[1][2], y[1][3]); w0.z = cvt_pk_bf16(y[1][4], y[1][5]); w0.w = cvt_pk_bf16(y[1][6], y[1][7]);
        w1.x = cvt_pk_bf16(y[1][8], y[1][9]); w1.y = cvt_pk_bf16(y[1][10], y[1][11]); w1.z = cvt_pk_bf16(y[1][12], y[1][13]); w1.w = cvt_pk_bf16(y[1][14], y[1][15]);
        *(LAS u32x4*)(Kl + t * 136 + ch0) = w0; *(LAS u32x4*)(Kl + t * 136 + ch0 + 8) = w1;
        w0.x = cvt_pk_bf16(y[0][0], y[0][1]); w0.y = cvt_pk_bf16(y[0][2], y[0][3]); w0.z = cvt_pk_bf16(y[0][4], y[0][5]); w0.w = cvt_pk_bf16(y[0][6], y[0][7]);
        w1.x = cvt_pk_bf16(y[0][8], y[0][9]); w1.y = cvt_pk_bf16(y[0][10], y[0][11]); w1.z = cvt_pk_bf16(y[0][12], y[0][13]); w1.w = cvt_pk_bf16(y[0][14], y[0][15]);
        *(LAS u32x4*)(Ql + t * 136 + ch0) = w0; *(LAS u32x4*)(Ql + t * 136 + ch0 + 8) = w1;
#pragma unroll
        for (int e = 0; e < 4; ++e) { *(LAS f32x4*)(RHS + t * RHSP + ch0 + 4 * e) = (f32x4){bt * y[2][4 * e], bt * y[2][4 * e + 1], bt * y[2][4 * e + 2], bt * y[2][4 * e + 3]};
            const float be = bt * egt; *(LAS f32x4*)(RHS + t * RHSP + 128 + ch0 + 4 * e) = (f32x4){be * y[1][4 * e], be * y[1][4 * e + 1], be * y[1][4 * e + 2], be * y[1][4 * e + 3]}; }
#pragma unroll
        for (int e = 0; e < 4; ++e) { u32x2 w; w.x = cvt_pk_bf16(y[0][4 * e] * egt, y[0][4 * e + 1] * egt); w.y = cvt_pk_bf16(y[0][4 * e + 2] * egt, y[0][4 * e + 3] * egt);
            *(u32x2*)(QD + t * 128 + 32 * (cg8 >> 1) + 8 * e + 4 * (cg8 & 1)) = w; }
    }
    __syncthreads();
    {
        const int fr = lane & 15, fq = lane >> 4, ti = wid >> 1, jp = wid & 1;
        f32x4 kk[2], qk[2];
#pragma unroll
        for (int e = 0; e < 2; ++e) { kk[e] = (f32x4){0.f, 0.f, 0.f, 0.f}; qk[e] = (f32x4){0.f, 0.f, 0.f, 0.f}; }
#pragma unroll
        for (int ks = 0; ks < 4; ++ks) { const bf16x8 bK = *(const LAS bf16x8*)(Kl + (16 * ti + fr) * 136 + 32 * ks + 8 * fq), bQ = *(const LAS bf16x8*)(Ql + (16 * ti + fr) * 136 + 32 * ks + 8 * fq);
#pragma unroll
            for (int e = 0; e < 2; ++e) { const bf16x8 a = *(const LAS bf16x8*)(Kl + (16 * (2 * jp + e) + fr) * 136 + 32 * ks + 8 * fq);
                kk[e] = __builtin_amdgcn_mfma_f32_16x16x32_bf16(a, bK, kk[e], 0, 0, 0); qk[e] = __builtin_amdgcn_mfma_f32_16x16x32_bf16(a, bQ, qk[e], 0, 0, 0); } }
        const int t = 16 * ti + fr; const float gct = GC[t];
        float av[8];
#pragma unroll
        for (int e = 0; e < 2; ++e) { f32x4 lv;
#pragma unroll
            for (int r = 0; r < 4; ++r) { const int s = 16 * (2 * jp + e) + 4 * fq + r; const float gcs = GC[s]; const float dec = __expf(fminf(gct - gcs, 0.f)), dec2 = __expf(fminf(gcs - gct, 0.f));
                lv[r] = (t < s) ? BETA[s] * kk[e][r] * dec2 : 0.f; av[4 * e + r] = (s <= t) ? qk[e][r] * dec : 0.f; }
            *(LAS f32x4*)(Ll + t * 64 + 16 * (2 * jp + e) + 4 * fq) = lv; }
        u32x4 w; w.x = cvt_pk_bf16(av[0], av[1]); w.y = cvt_pk_bf16(av[2], av[3]); w.z = cvt_pk_bf16(av[4], av[5]); w.w = cvt_pk_bf16(av[6], av[7]);
        *(u32x4*)(ATT + t * 64 + 32 * jp + 8 * fq) = w;
    }
    __syncthreads();
    if (wid < 4) {
        const int col = 64 * wid + lane;
        int vz; asm volatile("v_mov_b32 %0, 0" : "=v"(vz));
        const LAS float* Lz = Ll + 4 * vz;
        float x[64];
#pragma unroll
        for (int i = 0; i < 64; ++i) x[i] = RHS[i * RHSP + col];
#pragma unroll
        for (int m = 0; m < 63; ++m) { const float xm = x[m];
#pragma unroll
            for (int g4 = (m + 1) / 4; g4 < 16; ++g4) { const f32x4 l4 = *(const LAS f32x4*)(Lz + m * 64 + 4 * g4);
                x[4 * g4] -= l4.x * xm; x[4 * g4 + 1] -= l4.y * xm; x[4 * g4 + 2] -= l4.z * xm; x[4 * g4 + 3] -= l4.w * xm; } }
        if (wid < 2) {
#pragma unroll
            for (int j = 0; j < 8; ++j) { u32x4 w; w.x = cvt_pk_bf16(x[8 * j], x[8 * j + 1]); w.y = cvt_pk_bf16(x[8 * j + 2], x[8 * j + 3]); w.z = cvt_pk_bf16(x[8 * j + 4], x[8 * j + 5]); w.w = cvt_pk_bf16(x[8 * j + 6], x[8 * j + 7]);
                *(u32x4*)(UT + col * 64 + 8 * j) = w; }
        } else {
            const int dk = col - 128, o = dk & 31; const int pos = (dk & ~31) + ((o < 16) ? (8 * (o >> 2) + (o & 3)) : (8 * ((o - 16) >> 2) + 4 + (o & 3)));
#pragma unroll
            for (int i = 0; i < 64; ++i) NW[i * 128 + pos] = (bf16_t)(cvt_pk_bf16(-x[i], 0.f) & 0xffffu);
        }
    } else {
        const int idx = tid - 256, dk = idx >> 1, th = idx & 1; const float gl = GC[63];
        float v[32];
#pragma unroll
        for (int pos = 0; pos < 32; ++pos) { const int a = pos >> 3, s = pos & 7; const int o = (s < 4) ? (4 * a + s) : (16 + 4 * a + s - 4); const int t = 32 * th + o;
            v[pos] = bf2f(Kl[t * 136 + dk]) * __expf(gl - GC[t]); }
#pragma unroll
        for (int j = 0; j < 4; ++j) { u32x4 w; w.x = cvt_pk_bf16(v[8 * j], v[8 * j + 1]); w.y = cvt_pk_bf16(v[8 * j + 2], v[8 * j + 3]); w.z = cvt_pk_bf16(v[8 * j + 4], v[8 * j + 5]); w.w = cvt_pk_bf16(v[8 * j + 6], v[8 * j + 7]);
            *(u32x4*)(KTT + dk * 64 + 32 * th + 8 * j) = w; }
    }
    __syncthreads();
}

constexpr int GS_NW = 0, GS_QD = 17408, GS_ATT = 34816, GS_KTT = 44032, GS_UT = 62464, GS_OL = 80896;
__device__ __forceinline__ void gdn_scan(LAS unsigned char* lds, const Params& P, int bh, int tid, int wid, int lane) {
    LAS bf16_t* NWl = (LAS bf16_t*)(lds + GS_NW); LAS bf16_t* QDl = (LAS bf16_t*)(lds + GS_QD); LAS bf16_t* ATTl = (LAS bf16_t*)(lds + GS_ATT);
    LAS bf16_t* KTTl = (LAS bf16_t*)(lds + GS_KTT); LAS bf16_t* UTl = (LAS bf16_t*)(lds + GS_UT); LAS float* OL = (LAS float*)(lds + GS_OL);
    const int b = bh >> 2, h = bh & 3, fr = lane & 15, fq = lane >> 4;
    const bf16_t* PJ = (const bf16_t*)(P.ws + WS_BIG); bf16_t* MIX = (bf16_t*)(P.ws + WS_A);
    const float* EGL = (const float*)(P.ws + WS_MISC + MISC_EGL) + (size_t)bh * 128;
    const u32x4* gNW = (const u32x4*)(P.ws + WS_NW) + (size_t)bh * 128 * 1024; const u32x4* gQD = (const u32x4*)(P.ws + WS_QD) + (size_t)bh * 128 * 1024;
    const u32x4* gATT = (const u32x4*)(P.ws + WS_ATT) + (size_t)bh * 128 * 512; const u32x4* gKTT = (const u32x4*)(P.ws + WS_KTT) + (size_t)bh * 128 * 1024; const u32x4* gUT = (const u32x4*)(P.ws + WS_UT) + (size_t)bh * 128 * 1024;
    const int ot = tid >> 3, og = tid & 7;
    f32x4 Sacc[8];
#pragma unroll
    for (int m = 0; m < 8; ++m) Sacc[m] = (f32x4){0.f, 0.f, 0.f, 0.f};
    u32x4 rNW[2], rQD[2], rATT, rKTT[2], rUT[2]; float egl_n;
#define GS_GLOAD(c) do { _Pragma("unroll") for (int i_ = 0; i_ < 2; ++i_) { rNW[i_] = gNW[(size_t)(c) * 1024 + tid + 512 * i_]; rQD[i_] = gQD[(size_t)(c) * 1024 + tid + 512 * i_]; \
        rKTT[i_] = gKTT[(size_t)(c) * 1024 + tid + 512 * i_]; rUT[i_] = gUT[(size_t)(c) * 1024 + tid + 512 * i_]; } rATT = gATT[(size_t)(c) * 512 + tid]; egl_n = EGL[c]; } while (0)
    GS_GLOAD(0);
    for (int c = 0; c < 128; ++c) {
#pragma unroll
        for (int i = 0; i < 2; ++i) { const int p = tid + 512 * i;
            *(LAS u32x4*)(NWl + (p >> 4) * 136 + (p & 15) * 8) = rNW[i]; *(LAS u32x4*)(QDl + (p >> 4) * 136 + (p & 15) * 8) = rQD[i];
            *(LAS u32x4*)(KTTl + (p >> 3) * 72 + (p & 7) * 8) = rKTT[i]; *(LAS u32x4*)(UTl + (p >> 3) * 72 + (p & 7) * 8) = rUT[i]; }
        *(LAS u32x4*)(ATTl + (tid >> 3) * 72 + (tid & 7) * 8) = rATT;
        const float egl = egl_n;
        __syncthreads();
        if (c + 1 < 128) GS_GLOAD(c + 1);
        const size_t R = (size_t)b * SEQ + (size_t)c * 64 + ot;
        const u32x4 gz0 = *(const u32x4*)(PJ + R * 3072 + 2560 + h * 128 + 16 * og), gz1 = *(const u32x4*)(PJ + R * 3072 + 2560 + h * 128 + 16 * og + 8);
        bf16x8 Bs[4];
#pragma unroll
        for (int ks = 0; ks < 4; ++ks) { u32x4 w; w.x = cvt_pk_bf16(Sacc[2 * ks][0], Sacc[2 * ks][1]); w.y = cvt_pk_bf16(Sacc[2 * ks][2], Sacc[2 * ks][3]);
            w.z = cvt_pk_bf16(Sacc[2 * ks + 1][0], Sacc[2 * ks + 1][1]); w.w = cvt_pk_bf16(Sacc[2 * ks + 1][2], Sacc[2 * ks + 1][3]); Bs[ks] = __builtin_bit_cast(bf16x8, w); }
        f32x4 VN[4], OA[4];
#pragma unroll
        for (int mt = 0; mt < 4; ++mt) { const u32x2 u2 = *(const LAS u32x2*)(UTl + (16 * wid + fr) * 72 + 16 * mt + 4 * fq);
            VN[mt] = (f32x4){bflo(u2.x), bfhi(u2.x), bflo(u2.y), bfhi(u2.y)}; OA[mt] = (f32x4){0.f, 0.f, 0.f, 0.f}; }
#pragma unroll
        for (int ks = 0; ks < 4; ++ks)
#pragma unroll
            for (int mt = 0; mt < 4; ++mt) { const bf16x8 a = *(const LAS bf16x8*)(NWl + (16 * mt + fr) * 136 + 32 * ks + 8 * fq), q = *(const LAS bf16x8*)(QDl + (16 * mt + fr) * 136 + 32 * ks + 8 * fq);
                VN[mt] = __builtin_amdgcn_mfma_f32_16x16x32_bf16(a, Bs[ks], VN[mt], 0, 0, 0); OA[mt] = __builtin_amdgcn_mfma_f32_16x16x32_bf16(q, Bs[ks], OA[mt], 0, 0, 0); }
        bf16x8 Bv[2];
#pragma unroll
        for (int k2 = 0; k2 < 2; ++k2) { u32x4 w; w.x = cvt_pk_bf16(VN[2 * k2][0], VN[2 * k2][1]); w.y = cvt_pk_bf16(VN[2 * k2][2], VN[2 * k2][3]);
            w.z = cvt_pk_bf16(VN[2 * k2 + 1][0], VN[2 * k2 + 1][1]); w.w = cvt_pk_bf16(VN[2 * k2 + 1][2], VN[2 * k2 + 1][3]); Bv[k2] = __builtin_bit_cast(bf16x8, w); }
#pragma unroll
        for (int k2 = 0; k2 < 2; ++k2)
#pragma unroll
            for (int mt = 0; mt < 4; ++mt) { const bf16x8 a = *(const LAS bf16x8*)(ATTl + (16 * mt + fr) * 72 + 32 * k2 + 8 * fq);
                OA[mt] = __builtin_amdgcn_mfma_f32_16x16x32_bf16(a, Bv[k2], OA[mt], 0, 0, 0); }
#pragma unroll
        for (int m = 0; m < 8; ++m) Sacc[m] = Sacc[m] * egl;
#pragma unroll
        for (int k2 = 0; k2 < 2; ++k2)
#pragma unroll
            for (int m = 0; m < 8; ++m) { const bf16x8 a = *(const LAS bf16x8*)(KTTl + (16 * m + fr) * 72 + 32 * k2 + 8 * fq);
                Sacc[m] = __builtin_amdgcn_mfma_f32_16x16x32_bf16(a, Bv[k2], Sacc[m], 0, 0, 0); }
#pragma unroll
        for (int mt = 0; mt < 4; ++mt)
#pragma unroll
            for (int r = 0; r < 4; ++r) OL[(16 * mt + 4 * fq + r) * 132 + 16 * wid + fr] = OA[mt][r];
        __syncthreads();
        {
            f32x4 ov[4], gain[4]; float ss = 0.f;
#pragma unroll
            for (int e = 0; e < 4; ++e) gain[e] = *(const f32x4*)(P.in[13] + 16 * og + 4 * e);
#pragma unroll
            for (int e = 0; e < 4; ++e) { ov[e] = *(const LAS f32x4*)(OL + ot * 132 + 16 * og + 4 * e); ss += (ov[e].x * ov[e].x + ov[e].y * ov[e].y) + (ov[e].z * ov[e].z + ov[e].w * ov[e].w); }
#pragma unroll
            for (int o = 1; o < 8; o <<= 1) ss += __shfl_xor(ss, o);
            const float rs = rsqrtf(ss * (1.0f / 128.0f) + EPSN);
            float z[16];
#pragma unroll
            for (int e = 0; e < 4; ++e) { z[2 * e] = bflo(gz0[e]); z[2 * e + 1] = bfhi(gz0[e]); z[8 + 2 * e] = bflo(gz1[e]); z[8 + 2 * e + 1] = bfhi(gz1[e]); }
            float r16[16];
#pragma unroll
            for (int e = 0; e < 4; ++e) { r16[4 * e] = ov[e].x * rs * gain[e].x * pg8::silu_f(z[4 * e]); r16[4 * e + 1] = ov[e].y * rs * gain[e].y * pg8::silu_f(z[4 * e + 1]);
                r16[4 * e + 2] = ov[e].z * rs * gain[e].z * pg8::silu_f(z[4 * e + 2]); r16[4 * e + 3] = ov[e].w * rs * gain[e].w * pg8::silu_f(z[4 * e + 3]); }
            u32x4 w0, w1;
            w0.x = cvt_pk_bf16(r16[0], r16[1]); w0.y = cvt_pk_bf16(r16[2], r16[3]); w0.z = cvt_pk_bf16(r16[4], r16[5]); w0.w = cvt_pk_bf16(r16[6], r16[7]);
            w1.x = cvt_pk_bf16(r16[8], r16[9]); w1.y = cvt_pk_bf16(r16[10], r16[11]); w1.z = cvt_pk_bf16(r16[12], r16[13]); w1.w = cvt_pk_bf16(r16[14], r16[15]);
            bf16_t* dst = MIX + R * 1024 + 512 + h * 128 + 16 * og;
            *(u32x4*)dst = w0; *(u32x4*)(dst + 8) = w1;
        }
    }
#undef GS_GLOAD
    __syncthreads();
}

#if defined(__HIP_DEVICE_COMPILE__)
__device__ __forceinline__ Params getp() { auto k = __builtin_amdgcn_kernarg_segment_ptr(); asm volatile("" : "+s"(k)); return *(const Params __attribute__((address_space(4)))*)k; }
#else
__device__ __forceinline__ Params getp() { return Params{}; }
#endif
#define GEMM_BF16(Aptr, Bptr, M_, N_, K_, Optr, ldc_, scale_, coff_) do { const Params P = getp(); unsigned char* ws = P.ws; (void)ws; \
        pg8::Gemm g{(const bf16_t*)(Aptr), (const bf16_t*)(Bptr), (M_), (N_), (K_)}; pg8::StaticOrder S; S.init((M_), (N_), G, (bid + (coff_)) % G); pg8::EpiBf16 E{(bf16_t*)(Optr), (ldc_), (scale_)}; \
        _Pragma("unroll") for (int rep_ = 0; rep_ < GEMM_REPS; ++rep_) pg8::gemm_phase<pg8::EpiBf16, pg8::StaticOrder, true, true>(lds, g, S, E); } while (0)
#define GEMM_SWIGLU(Bptr) do { const Params P = getp(); unsigned char* ws = P.ws; \
        pg8::Gemm g{(const bf16_t*)(ws + WS_A), (const bf16_t*)(Bptr), MTOK, 2 * DFF, DM}; pg8::StaticOrder S; S.init(MTOK, 2 * DFF, G, bid); pg8::EpiSwiGLU E{(bf16_t*)(ws + WS_BIG), DFF}; \
        _Pragma("unroll") for (int rep_ = 0; rep_ < GEMM_REPS; ++rep_) pg8::gemm_phase<pg8::EpiSwiGLU, pg8::StaticOrder, true, true>(lds, g, S, E); } while (0)
#define ROW_PHASE(hin_, gpost_, w_, gnext_, hasA_) do { PH_IDS const Params P = getp(); unsigned char* ws = P.ws; \
        row_phase((hin_), (const bf16_t*)(ws + WS_F), (gpost_), (w_), P.out, (gnext_), (hasA_) ? (bf16_t*)(ws + WS_A) : nullptr, MTOK, gw, ngw, lane); } while (0)
#define GSYNC() cg::this_grid().sync()
#ifndef GEMM_REPS
#define GEMM_REPS 1
#endif

__global__ void __launch_bounds__(512, 2) hymba_fwd(Params Parg) {
    extern __shared__ __attribute__((aligned(16))) unsigned char lds_raw[];
    LAS unsigned char* lds = (LAS unsigned char*)lds_raw;
    const int G = gridDim.x, bid = blockIdx.x;
#define PH_IDS int tid_l = threadIdx.x; asm volatile("" : "+v"(tid_l)); const int tid = tid_l, lane = tid & 63, wid = __builtin_amdgcn_readfirstlane(tid >> 6), gw = bid * 8 + wid, ngw = G * 8; (void)gw; (void)ngw; (void)lane; \
        volatile LAS unsigned* bc = (volatile LAS unsigned*)(lds + LDS_BCAST); (void)bc;

    {
        PH_IDS const Params P = getp(); unsigned char* ws = P.ws;
        LAS float* scr = (LAS float*)(lds + wid * 16384);
        if (bid == 0 && tid < 64) { unsigned* ctl = (unsigned*)(ws + WS_CTL); ctl[64 * tid] = 0u; }
        transpose_all(P.in[3], DM, DFF, (bf16_t*)(ws + WS_WGU1), MapGate{}, scr, gw, ngw, lane);
        transpose_all(P.in[4], DM, DFF, (bf16_t*)(ws + WS_WGU1), MapUp{}, scr, gw, ngw, lane);
        transpose_all(P.in[5], DFF, DM, (bf16_t*)(ws + WS_WD1), MapIdent{0}, scr, gw, ngw, lane);
        transpose_all(P.in[8], DM, 3600, (bf16_t*)(ws + WS_WIN), MapWin{}, scr, gw, ngw, lane);
        transpose_all(P.in[8], DM, 3600, (bf16_t*)(ws + WS_WVT), MapWinV{}, scr, gw, ngw, lane);
        transpose_all(P.in[14], DM, DM, (bf16_t*)(ws + WS_WOUT), MapIdent{0}, scr, gw, ngw, lane);
        transpose_all(P.in[18], DM, DM, (bf16_t*)(ws + WS_WQ), MapIdent{0}, scr, gw, ngw, lane);
        transpose_all(P.in[19], DM, 2 * DM, (bf16_t*)(ws + WS_WKV), MapIdent{0}, scr, gw, ngw, lane);
        transpose_all(P.in[20], DM, DM, (bf16_t*)(ws + WS_WO), MapIdent{0}, scr, gw, ngw, lane);
        transpose_all(P.in[23], DM, DFF, (bf16_t*)(ws + WS_WGU2), MapGate{}, scr, gw, ngw, lane);
        transpose_all(P.in[24], DM, DFF, (bf16_t*)(ws + WS_WGU2), MapUp{}, scr, gw, ngw, lane);
        transpose_all(P.in[25], DFF, DM, (bf16_t*)(ws + WS_WD2), MapIdent{0}, scr, gw, ngw, lane);
        {
            u32x4* z = (u32x4*)((bf16_t*)(ws + WS_WIN) + (size_t)3088 * DM); const int n16 = 240 * DM / 8;
            for (int i = bid * 512 + tid; i < n16; i += G * 512) z[i] = (u32x4){0u, 0u, 0u, 0u};
        }
        row_phase(P.in[0], nullptr, nullptr, 0.f, nullptr, P.in[2], (bf16_t*)(ws + WS_A), MTOK, gw, ngw, lane);
        row_phase(P.in[1], nullptr, nullptr, 0.f, nullptr, P.in[17], (bf16_t*)(ws + WS_AMEM), NB * NMEM, gw, ngw, lane);
    }
    GSYNC();
#if defined(STOP_AFTER)
    if (STOP_AFTER == 0) return;
#endif
    GEMM_SWIGLU(ws + WS_WGU1);
    GEMM_BF16(ws + WS_AMEM, ws + WS_WKV, NB * NMEM, DM, DM, ws + WS_KMEM, DM, 1.f, 64);
    GEMM_BF16((const bf16_t*)(ws + WS_WKV) + (size_t)DM * DM, ws + WS_AMEM, DM, NB * NMEM, DM, ws + WS_VMEMT, NB * NMEM, 1.f, 128);
    GSYNC();
#if defined(STOP_AFTER)
    if (STOP_AFTER == 1) return;
#endif
    GEMM_BF16(ws + WS_BIG, ws + WS_WD1, MTOK, DM, DFF, ws + WS_F, DM, 1.f, 0);
    GSYNC();
#if defined(STOP_AFTER)
    if (STOP_AFTER == 2) return;
#endif
    ROW_PHASE(P.in[0], P.in[6], 0.5f, P.in[7], true);
    GSYNC();
#if defined(STOP_AFTER)
    if (STOP_AFTER == 3) return;
#endif
    { const Params P = getp(); unsigned char* ws = P.ws;
      pg8::Gemm g{(const bf16_t*)(ws + WS_A), (const bf16_t*)(ws + WS_WIN), MTOK, 3328, DM}; pg8::StaticOrder S; S.init(MTOK, 3328, G, bid); pg8::EpiProj E{(bf16_t*)(ws + WS_BIG), (float*)(ws + WS_SM), FOX_QSCALE};
      _Pragma("unroll") for (int rep_ = 0; rep_ < GEMM_REPS; ++rep_) pg8::gemm_phase<pg8::EpiProj, pg8::StaticOrder, true, true>(lds, g, S, E); }
    GEMM_BF16(ws + WS_WVT, ws + WS_A, 512, MTOK, DM, ws + WS_VT, MTOK, 1.f, 0);
    GSYNC();
#if defined(STOP_AFTER)
    if (STOP_AFTER == 4) return;
#endif
    { PH_IDS const Params P = getp(); unsigned* ctl = (unsigned*)(P.ws + WS_CTL);
#ifndef P5_REPS
#define P5_REPS 1
#endif
      {
      if ((bid & 3) == 0) fox_prep(lds, P, bid >> 2, tid, wid, lane);
      const int grp = bid >> 3;
      for (;;) { if (tid == 0) *bc = atomicAdd(ctl + 64 * grp, 1u); __syncthreads(); const int cl = (int)*bc; __syncthreads(); if (cl >= 128) break; const int ci = grp * 128 + cl;
#if !defined(SKIP_P5G)
          gdn_prep_chunk(lds, P, ci, tid, wid, lane);
#endif
          } } }
    GSYNC();
#if defined(STOP_AFTER)
    if (STOP_AFTER == 5) return;
#endif
#if defined(DUMP_PREP)
    { PH_IDS const Params P = getp(); unsigned char* ws = P.ws; const bf16_t* s0 = (const bf16_t*)(ws + DUMP_A); const bf16_t* s1 = (const bf16_t*)(ws + DUMP_B);
      for (int i = bid * 512 + tid; i < 4096 * 8192; i += G * 512) { float a = bf2f(s0[i]), b = bf2f(s1[i]); if (!(fabsf(a) < 1e30f)) a = 1e4f; if (!(fabsf(b) < 1e30f)) b = 1e4f;
          if (fabsf(a) > 100.f) a = 3e3f; if (fabsf(b) > 100.f) b = 3e3f; P.out[i] = a; P.out[4096 * 8192 + i] = b; } }
    return;
#endif
    { PH_IDS const Params P = getp(); unsigned char* ws = P.ws; unsigned* ctl = (unsigned*)(ws + WS_CTL);
#ifndef P6_REPS
#define P6_REPS 1
#endif
      {
#if defined(SKIP_GDN)
      for (int i = bid * 512 + tid; i < MTOK * 64; i += G * 512) { ((u32x4*)(ws + WS_A))[(i >> 6) * 128 + 64 + (i & 63)] = (u32x4){0u, 0u, 0u, 0u}; }
#else
      if ((bid & 7) == 0) gdn_scan(lds, P, bid >> 3, tid, wid, lane);
#endif
#if defined(SKIP_FOX)
      for (int i = bid * 512 + tid; i < MTOK * 64; i += G * 512) { ((u32x4*)(ws + WS_A))[(i >> 6) * 128 + (i & 63)] = (u32x4){0u, 0u, 0u, 0u}; }
#endif
      const int* KT0 = (const int*)(ws + WS_MISC + MISC_KT0); const bf16_t* PJ = (const bf16_t*)(ws + WS_BIG);
#if defined(SKIP_FOX)
      if (0)
#endif
      const int grp = bid >> 3;
      for (;;) { if (tid == 0) *bc = atomicAdd(ctl + 2048 + 64 * grp, 1u); __syncthreads(); const int ul = (int)*bc; __syncthreads(); if (ul >= 128) break; const int idx = ul * 32 + grp;
          const int qb = 63 - (idx >> 6), bh = idx & 63, b = bh >> 3, h = bh & 7;
          const int kt0 = KT0[bh * 64 + qb];
          attn_unit<64, true>(lds, PJ + (size_t)b * SEQ * 3072 + h * 64, 3072, PJ + (size_t)b * SEQ * 3072 + 512 + h * 64, 3072,
                              (const bf16_t*)(ws + WS_VT) + (size_t)(h * 64) * MTOK + (size_t)b * SEQ, MTOK, (bf16_t*)(ws + WS_A) + (size_t)b * SEQ * 1024 + h * 64, 1024,
                              (const float*)(ws + WS_FC) + (size_t)bh * SEQ, qb, kt0, 2 * qb + 1, tid, wid, lane); } } }
    GSYNC();
#if defined(STOP_AFTER)
    if (STOP_AFTER == 6) return;
#endif
#if defined(DUMP_MIX)
    { PH_IDS const Params P = getp(); unsigned char* ws = P.ws; const bf16_t* s0 = (const bf16_t*)(ws + WS_A);
      for (int i = bid * 512 + tid; i < MTOK * 1024; i += G * 512) { float a = bf2f(s0[i]); if (!(fabsf(a) < 1e30f)) a = 1e4f; else if (fabsf(a) > 100.f) a = 3e3f;
#if defined(DUMP_MASK0)
          if ((((i >> 10) & 8191) >> 6) == DUMP_MASK0) a = 0.f;
#endif
          P.out[i] = a; } }
    return;
#endif
    GEMM_BF16(ws + WS_A, ws + WS_WOUT, MTOK, DM, DM, ws + WS_F, DM, 1.f, 0);
    GSYNC();
#if defined(STOP_AFTER)
    if (STOP_AFTER == 7) return;
#endif
    ROW_PHASE(P.out, P.in[15], 1.0f, P.in[16], true);
    GSYNC();
#if defined(STOP_AFTER)
    if (STOP_AFTER == 8) return;
#endif
    GEMM_BF16(ws + WS_A, ws + WS_WQ, MTOK, DM, DM, ws + WS_F, DM, MEM_QSCALE, 0);
    GSYNC();
#if defined(STOP_AFTER)
    if (STOP_AFTER == 9) return;
#endif
    { PH_IDS const Params P = getp(); unsigned char* ws = P.ws;
#if !defined(SKIP_P10)
#ifndef P10_REPS
#define P10_REPS 1
#endif
      for (int rep10 = 0; rep10 < P10_REPS; ++rep10)
      for (int idx = bid; idx < 2048; idx += G) { const int qb = idx & 63, bhm = idx >> 6, b = bhm >> 2, h = bhm & 3;
          attn_unit<256, false>(lds, (const bf16_t*)(ws + WS_F) + (size_t)b * SEQ * 1024 + h * 256, 1024, (const bf16_t*)(ws + WS_KMEM) + (size_t)b * NMEM * 1024 + h * 256, 1024,
                                (const bf16_t*)(ws + WS_VMEMT) + (size_t)(h * 256) * (NB * NMEM) + (size_t)b * NMEM, NB * NMEM, (bf16_t*)(ws + WS_A) + (size_t)b * SEQ * 1024 + h * 256, 1024,
                                nullptr, qb, 0, 3, tid, wid, lane); }
#endif
    }
    GSYNC();
#if defined(STOP_AFTER)
    if (STOP_AFTER == 10) return;
#endif
    GEMM_BF16(ws + WS_A, ws + WS_WO, MTOK, DM, DM, ws + WS_F, DM, 1.f, 0);
    GSYNC();
#if defined(STOP_AFTER)
    if (STOP_AFTER == 11) return;
#endif
    ROW_PHASE(P.out, P.in[21], 1.0f, P.in[22], true);
    GSYNC();
#if defined(STOP_AFTER)
    if (STOP_AFTER == 12) return;
#endif
    GEMM_SWIGLU(ws + WS_WGU2);
    GSYNC();
#if defined(STOP_AFTER)
    if (STOP_AFTER == 13) return;
#endif
    GEMM_BF16(ws + WS_BIG, ws + WS_WD2, MTOK, DM, DFF, ws + WS_F, DM, 1.f, 0);
    GSYNC();
#if defined(STOP_AFTER)
    if (STOP_AFTER == 14) return;
#endif
    ROW_PHASE(P.out, P.in[26], 0.5f, (const float*)nullptr, false);
}

extern "C" void kernel_launch(void* const* d_in, const int* in_sizes, int n_in, void* d_out, int out_size, void* d_ws, size_t ws_size, hipStream_t stream) {
    static int grid = 0;
    if (grid == 0) {
        if (n_in != 27 || ws_size < WS_END) { fprintf(stderr, "kernel_launch: unexpected inputs (n_in %d, ws %zu)\n", n_in, ws_size); grid = -1; return; }
        int dev = 0, cus = 0, per_cu = 0;
        hipGetDevice(&dev); hipDeviceGetAttribute(&cus, hipDeviceAttributeMultiprocessorCount, dev);
        hipFuncSetAttribute((const void*)hymba_fwd, hipFuncAttributeMaxDynamicSharedMemorySize, LDS_BYTES);
        hipOccupancyMaxActiveBlocksPerMultiprocessor(&per_cu, (const void*)hymba_fwd, 512, LDS_BYTES);
        if (per_cu < 1) per_cu = 1;
        grid = cus * per_cu;
        fprintf(stderr, "kernel_launch: grid %d (%d CUs x %d)\n", grid, cus, per_cu);
    }
    if (grid < 0) return;
    Params p{};
    for (int i = 0; i < 27; ++i) p.in[i] = (const float*)d_in[i];
    p.out = (float*)d_out; p.ws = (unsigned char*)d_ws;
    void* args[] = {&p};
    hipError_t e = hipLaunchCooperativeKernel((const void*)hymba_fwd, dim3(grid), dim3(512), args, LDS_BYTES, stream);
    if (e != hipSuccess) fprintf(stderr, "kernel_launch: cooperative launch failed: %s (grid %d)\n", hipGetErrorString(e), grid);
}
```

```cpp
#include <hip/hip_runtime.h>
#include <hip/hip_cooperative_groups.h>
#include <cstdio>
#include <cstdint>
namespace cg = cooperative_groups;

namespace pg8 {
#define PG8_LAS __attribute__((address_space(3)))
typedef unsigned short bf16_t;
typedef short bf16x8 __attribute__((ext_vector_type(8)));
typedef float f32x4 __attribute__((ext_vector_type(4)));
typedef unsigned u32x4 __attribute__((ext_vector_type(4)));
constexpr int BM = 256, BK = 64, HALF = 128, HTB = HALF * BK * 2  , STAGE_BYTES = 8 * HTB, NXCD = 8, WGM = 8;

__host__ __device__ __forceinline__ int lds_byte(int r, int c) { const int st = (r >> 4) * 2 + (c >> 5), rr = r & 15, cc = c & 31, ob = rr * 64 + cc * 2; return st * 1024 + (ob ^ (((ob >> 9) & 1) << 5)); }
__host__ __device__ __forceinline__ void stage_rc(int b, int& R, int& C) { const int st = b / 1024, sb = b % 1024, swz = sb ^ (((sb >> 9) & 1) << 5); R = (st >> 1) * 16 + swz / 64; C = (st & 1) * 32 + (swz % 64) / 2; }
__host__ __device__ __forceinline__ int perm32(int rho) { const int n = rho >> 4, i = rho & 15; return 8 * (i >> 2) + 4 * n + (i & 3); }

struct Unit { int pm, pn; };
struct Gemm { const bf16_t* A; const bf16_t* Bt; int M, N, K; };

struct StaticOrder {
    int nM, nN, nwg, G, c;
    __host__ __device__ void init(int M, int N, int G_, int c_) { nM = M / BM; nN = N / BM; nwg = nM * nN; G = G_; c = c_; }
    __host__ __device__ bool next(int i, Unit& u) const {
        const long L = (long)i * G + c; if (L >= nwg) return false;
        int wgid = (int)L; { const int q = nwg / NXCD, r = nwg % NXCD, xcd = wgid % NXCD, off = wgid / NXCD; wgid = (xcd < r ? xcd * (q + 1) : r * (q + 1) + (xcd - r) * q) + off; }
        const int nig = WGM * nN, gid = wgid / nig, fm = gid * WGM, gsz = (nM - fm) < WGM ? (nM - fm) : WGM;
        u.pm = fm + ((wgid % nig) % gsz); u.pn = (wgid % nig) / gsz; return true;
    }
    __device__ __forceinline__ void a_ready(const Unit&) const {}
    __device__ __forceinline__ void done(const Unit&) const {}
};

typedef float f32x2_t __attribute__((ext_vector_type(2))); typedef __bf16 bf16x2_t __attribute__((ext_vector_type(2)));
__device__ __forceinline__ unsigned cvt_pk_bf16(float lo, float hi) { f32x2_t v = {lo, hi}; bf16x2_t b = __builtin_convertvector(v, bf16x2_t); return __builtin_bit_cast(unsigned, b); }
struct EpiBf16 {
    static constexpr bool PERM = true, AFTER_DRAIN = false;
    bf16_t* O; int ldc; float scale;
    __device__ __forceinline__ void operator()(const f32x4 (&acc)[2][2][4][2], const Unit& u, int wr, int wc, int fr, int fq) const {
        const int row0 = u.pm * BM + wr * 64 + fr; const int col0 = u.pn * BM + wc * 32 + 8 * fq; const float sc = scale;
#pragma unroll
        for (int ai = 0; ai < 2; ++ai)
#pragma unroll
            for (int m = 0; m < 4; ++m) { bf16_t* rowp = O + (size_t)(row0 + ai * HALF + m * 16) * ldc + col0;
#pragma unroll
                for (int bj = 0; bj < 2; ++bj) { f32x4 v0 = acc[ai][bj][m][0] * sc, v1 = acc[ai][bj][m][1] * sc;
                    u32x4 w; w.x = cvt_pk_bf16(v0[0], v0[1]); w.y = cvt_pk_bf16(v0[2], v0[3]); w.z = cvt_pk_bf16(v1[0], v1[1]); w.w = cvt_pk_bf16(v1[2], v1[3]);
                    *(u32x4*)(rowp + bj * HALF) = w; } asm volatile("" ::: "memory"); }
    }
};
__device__ __forceinline__ float silu_f(float x) { return x * __builtin_amdgcn_rcpf(1.0f + __builtin_amdgcn_exp2f(-1.4426950408889634f * x)); }
struct EpiSwiGLU {
    static constexpr bool PERM = true, AFTER_DRAIN = false;
    bf16_t* O; int ldc;
    __device__ __forceinline__ void operator()(const f32x4 (&acc)[2][2][4][2], const Unit& u, int wr, int wc, int fr, int fq) const {
        const int row0 = u.pm * BM + wr * 64 + fr; const int col0 = u.pn * HALF + wc * 32 + 8 * fq;
#pragma unroll
        for (int ai = 0; ai < 2; ++ai)
#pragma unroll
            for (int m = 0; m < 4; ++m) { bf16_t* rowp = O + (size_t)(row0 + ai * HALF + m * 16) * ldc + col0;
                const f32x4 g0 = acc[ai][0][m][0], g1 = acc[ai][0][m][1], u0 = acc[ai][1][m][0], u1 = acc[ai][1][m][1];
                float h[8];
#pragma unroll
                for (int e = 0; e < 4; ++e) { h[e] = silu_f(g0[e]) * u0[e]; h[4 + e] = silu_f(g1[e]) * u1[e]; }
                u32x4 w; w.x = cvt_pk_bf16(h[0], h[1]); w.y = cvt_pk_bf16(h[2], h[3]); w.z = cvt_pk_bf16(h[4], h[5]); w.w = cvt_pk_bf16(h[6], h[7]);
                *(u32x4*)rowp = w; asm volatile("" ::: "memory"); }
    }
};
struct EpiProj {
    static constexpr bool PERM = true, AFTER_DRAIN = false;
    bf16_t* PJ; float* SM; float qscale;
    __device__ __forceinline__ void operator()(const f32x4 (&acc)[2][2][4][2], const Unit& u, int wr, int wc, int fr, int fq) const {
        const int row0 = u.pm * BM + wr * 64 + fr;
        if (u.pn < 12) {
            const int col0 = u.pn * BM + wc * 32 + 8 * fq; const float sc = (u.pn < 2) ? qscale : 1.0f;
#pragma unroll
            for (int ai = 0; ai < 2; ++ai)
#pragma unroll
                for (int m = 0; m < 4; ++m) { bf16_t* rowp = PJ + (size_t)(row0 + ai * HALF + m * 16) * 3072 + col0;
#pragma unroll
                    for (int bj = 0; bj < 2; ++bj) { f32x4 v0 = acc[ai][bj][m][0] * sc, v1 = acc[ai][bj][m][1] * sc;
                        u32x4 w; w.x = cvt_pk_bf16(v0[0], v0[1]); w.y = cvt_pk_bf16(v0[2], v0[3]); w.z = cvt_pk_bf16(v1[0], v1[1]); w.w = cvt_pk_bf16(v1[2], v1[3]);
                        *(u32x4*)(rowp + bj * HALF) = w; } asm volatile("" ::: "memory"); }
        } else if (wc == 0 && fq < 2) {
#pragma unroll
            for (int ai = 0; ai < 2; ++ai)
#pragma unroll
                for (int m = 0; m < 4; ++m) { float* rowp = SM + (size_t)(row0 + ai * HALF + m * 16) * 16 + 8 * fq;
                    *(f32x4*)rowp = acc[ai][0][m][0]; *(f32x4*)(rowp + 4) = acc[ai][0][m][1]; }
        }
    }
};
template <class Epi, class Sched, bool ALIGN_EPI = false, bool SP2 = false>
__device__ __forceinline__ void gemm_phase(PG8_LAS unsigned char* lds, const Gemm g, const Sched& S, const Epi& E) {
    int tid_l = threadIdx.x; asm volatile("" : "+v"(tid_l));
    const int tid = tid_l, wid = __builtin_amdgcn_readfirstlane(tid >> 6), lane = tid & 63, wr = wid >> 2, wc = wid & 3, fr = lane & 15, fq = lane >> 4;
    const int K = g.K, nt = K / BK;
    unsigned voffA[2], voffB[2];
#pragma unroll
    for (int i = 0; i < 2; ++i) { int R, C; stage_rc(tid * 16 + i * 8192, R, C); const int Rb = Epi::PERM ? ((R & ~31) + perm32(R & 31)) : R;
        voffA[i] = (unsigned)(R * K + C) * 2u; voffB[i] = (unsigned)(Rb * K + C) * 2u; }
    const size_t kstep = (size_t)(BK * 2);
    const size_t hstep = (size_t)HALF * K * 2;
    const size_t tstep = 2 * hstep;
    const unsigned ldsw = (unsigned)wid * 1024u;
    const int aoff = lds_byte(wr * 64 + fr, fq * 8), boff = lds_byte(wc * 32 + fr, fq * 8);
#define PG8_SA(b, h) (((b) * 2 + (h)) * HTB)
#define PG8_SB(b, h) ((4 + (b) * 2 + (h)) * HTB)
#define PG8_STAGE(bufoff, gbase, voff) do { _Pragma("unroll") for (int _i = 0; _i < 2; ++_i) \
        __builtin_amdgcn_global_load_lds((const unsigned*)((const char*)(gbase) + (voff)[_i]), (PG8_LAS unsigned*)(lds + (bufoff) + ldsw + _i * 8192), 16, 0, 0); } while (0)
#define PG8_LDA(dst, b, h) do { _Pragma("unroll") for (int m = 0; m < 4; ++m) _Pragma("unroll") for (int k = 0; k < 2; ++k) dst[m][k] = *(const PG8_LAS bf16x8*)(lds + PG8_SA(b, h) + aoff + m * 2048 + k * 1024); } while (0)
#define PG8_LDB(dst, b, h) do { _Pragma("unroll") for (int n = 0; n < 2; ++n) _Pragma("unroll") for (int k = 0; k < 2; ++k) dst[n][k] = *(const PG8_LAS bf16x8*)(lds + PG8_SB(b, h) + boff + n * 2048 + k * 1024); } while (0)
#define PG8_MMA(ai, bj, At, Bt) do { __builtin_amdgcn_s_setprio(1); _Pragma("unroll") for (int m = 0; m < 4; ++m) _Pragma("unroll") for (int n = 0; n < 2; ++n) _Pragma("unroll") for (int k = 0; k < 2; ++k) \
        acc[ai][bj][m][n] = __builtin_amdgcn_mfma_f32_16x16x32_bf16(Bt[n][k], At[m][k], acc[ai][bj][m][n], 0, 0, 0); __builtin_amdgcn_s_setprio(0); } while (0)
#define PG8_WAIT_V(n) asm volatile("s_waitcnt vmcnt(" #n ")" ::: "memory")
#define PG8_WAIT_L(n) asm volatile("s_waitcnt lgkmcnt(" #n ")" ::: "memory")
#define PG8_BAR __builtin_amdgcn_s_barrier()
#define PG8_SCHED __builtin_amdgcn_sched_barrier(0)
    Unit cur, nxt; int ui = 0;
    if (!S.next(0, cur)) return;
    f32x4 acc[2][2][4][2];
#pragma unroll
    for (int a = 0; a < 2; ++a)
#pragma unroll
        for (int b = 0; b < 2; ++b)
#pragma unroll
            for (int m = 0; m < 4; ++m)
#pragma unroll
                for (int n = 0; n < 2; ++n) acc[a][b][m][n] = (f32x4){0.f, 0.f, 0.f, 0.f};
    bf16x8 At[4][2], B0[2][2], B1[2][2];
    const char* cA = (const char*)g.A + (size_t)cur.pm * tstep; const char* cB = (const char*)g.Bt + (size_t)cur.pn * tstep;
    S.a_ready(cur);
    if constexpr (SP2) {
        PG8_STAGE(PG8_SB(0, 0), cB, voffB); PG8_STAGE(PG8_SB(0, 1), cB + hstep, voffB); PG8_STAGE(PG8_SA(0, 0), cA, voffA); PG8_STAGE(PG8_SA(0, 1), cA + hstep, voffA);
        if (wr == 1) PG8_BAR;
        PG8_WAIT_V(2); PG8_BAR;
        PG8_STAGE(PG8_SB(1, 0), cB + kstep, voffB); PG8_STAGE(PG8_SA(1, 0), cA + kstep, voffA); PG8_STAGE(PG8_SB(1, 1), cB + hstep + kstep, voffB);
        PG8_WAIT_V(6); PG8_BAR;
    } else {
        PG8_STAGE(PG8_SB(0, 0), cB, voffB); PG8_STAGE(PG8_SA(0, 0), cA, voffA); PG8_STAGE(PG8_SB(0, 1), cB + hstep, voffB); PG8_STAGE(PG8_SA(0, 1), cA + hstep, voffA);
        if (wr == 1) PG8_BAR;
        PG8_WAIT_V(4); PG8_BAR;
        PG8_STAGE(PG8_SB(1, 0), cB + kstep, voffB); PG8_STAGE(PG8_SA(1, 0), cA + kstep, voffA); PG8_STAGE(PG8_SB(1, 1), cB + hstep + kstep, voffB);
        PG8_WAIT_V(6); PG8_BAR;
    }
    for (;;) {
        const bool has_next = S.next(ui + 1, nxt);
        const char* nA = has_next ? (const char*)g.A + (size_t)nxt.pm * tstep : cA; const char* nB = has_next ? (const char*)g.Bt + (size_t)nxt.pn * tstep : cB;
        for (int t = 0; t < nt; t += 2) {
            const bool last = (t == nt - 2);
            const char* a1 = cA + (size_t)(t + 1) * kstep;
            const char* a2 = last ? nA : cA + (size_t)(t + 2) * kstep; const char* b2 = last ? nB : cB + (size_t)(t + 2) * kstep;
            const char* a3 = a2 + kstep; const char* b3 = b2 + kstep;
            if (last && has_next) S.a_ready(nxt);
            if constexpr (SP2) {
            PG8_LDB(B0, 0, 0); PG8_LDB(B1, 0, 1); PG8_SCHED; PG8_LDA(At, 0, 0); PG8_STAGE(PG8_SA(1, 1), a1 + hstep, voffA);
            PG8_WAIT_V(8); PG8_WAIT_L(0); PG8_BAR; PG8_MMA(0, 0, At, B0); PG8_MMA(0, 1, At, B1); PG8_BAR; PG8_SCHED;
            PG8_LDA(At, 0, 1); PG8_STAGE(PG8_SB(0, 0), b2, voffB); PG8_STAGE(PG8_SB(0, 1), b2 + hstep, voffB); PG8_STAGE(PG8_SA(0, 0), a2, voffA);
            PG8_WAIT_V(8); PG8_WAIT_L(0); PG8_BAR; PG8_MMA(1, 0, At, B0); PG8_MMA(1, 1, At, B1); PG8_BAR; PG8_SCHED;
            PG8_LDB(B0, 1, 0); PG8_LDB(B1, 1, 1); PG8_SCHED; PG8_LDA(At, 1, 0); PG8_STAGE(PG8_SA(0, 1), a2 + hstep, voffA);
            PG8_WAIT_V(8); PG8_WAIT_L(0); PG8_BAR; PG8_MMA(0, 0, At, B0); PG8_MMA(0, 1, At, B1); PG8_BAR; PG8_SCHED;
            PG8_LDA(At, 1, 1); PG8_STAGE(PG8_SB(1, 0), b3, voffB); PG8_STAGE(PG8_SB(1, 1), b3 + hstep, voffB); PG8_STAGE(PG8_SA(1, 0), a3, voffA);
            PG8_WAIT_V(8); PG8_WAIT_L(0); PG8_BAR; PG8_MMA(1, 0, At, B0); PG8_MMA(1, 1, At, B1); PG8_BAR; PG8_SCHED;
            } else {
            PG8_LDB(B0, 0, 0); PG8_SCHED; PG8_LDA(At, 0, 0); PG8_STAGE(PG8_SA(1, 1), a1 + hstep, voffA);
            PG8_WAIT_L(8); PG8_BAR; PG8_WAIT_L(0); PG8_MMA(0, 0, At, B0); PG8_BAR; PG8_SCHED;
            PG8_LDB(B1, 0, 1); PG8_STAGE(PG8_SB(0, 0), b2, voffB);
            PG8_BAR; PG8_WAIT_L(0); PG8_MMA(0, 1, At, B1); PG8_BAR;
            PG8_LDA(At, 0, 1); PG8_STAGE(PG8_SA(0, 0), a2, voffA);
            PG8_BAR; PG8_WAIT_L(0); PG8_MMA(1, 0, At, B0); PG8_BAR; PG8_SCHED;
            PG8_STAGE(PG8_SB(0, 1), b2 + hstep, voffB);
            PG8_WAIT_V(6); PG8_BAR; PG8_MMA(1, 1, At, B1); PG8_BAR;
            PG8_LDB(B0, 1, 0); PG8_SCHED; PG8_LDA(At, 1, 0); PG8_STAGE(PG8_SA(0, 1), a2 + hstep, voffA);
            PG8_WAIT_L(8); PG8_BAR; PG8_WAIT_L(0); PG8_MMA(0, 0, At, B0); PG8_BAR; PG8_SCHED;
            PG8_LDB(B1, 1, 1); PG8_STAGE(PG8_SB(1, 0), b3, voffB);
            PG8_BAR; PG8_WAIT_L(0); PG8_MMA(0, 1, At, B1); PG8_BAR;
            PG8_LDA(At, 1, 1); PG8_STAGE(PG8_SA(1, 0), a3, voffA);
            PG8_BAR; PG8_WAIT_L(0); PG8_MMA(1, 0, At, B0); PG8_BAR; PG8_SCHED;
            PG8_STAGE(PG8_SB(1, 1), b3 + hstep, voffB);
            PG8_WAIT_V(6); PG8_BAR; PG8_MMA(1, 1, At, B1); PG8_BAR;
            }
        }
        if constexpr (ALIGN_EPI) { if (wr == 0) PG8_BAR; }
        if constexpr (!Epi::AFTER_DRAIN) { E(acc, cur, wr, wc, fr, fq); S.done(cur); }
        if (!has_next) break;
#pragma unroll
        for (int a = 0; a < 2; ++a)
#pragma unroll
            for (int b = 0; b < 2; ++b)
#pragma unroll
                for (int m = 0; m < 4; ++m)
#pragma unroll
                    for (int n = 0; n < 2; ++n) acc[a][b][m][n] = (f32x4){0.f, 0.f, 0.f, 0.f};
        cur = nxt; cA = nA; cB = nB; ++ui;
        if constexpr (ALIGN_EPI) { if (wr == 1) PG8_BAR; }
    }
    PG8_WAIT_V(0);
    if constexpr (!ALIGN_EPI) { if (wr == 0) PG8_BAR; }
    PG8_BAR;
    if constexpr (Epi::AFTER_DRAIN) { E.fused(acc, cur, wr, wc, fr, fq, lds, wid, lane); S.done(cur); }
#undef PG8_SA
#undef PG8_SB
#undef PG8_STAGE
#undef PG8_LDA
#undef PG8_LDB
#undef PG8_MMA
#undef PG8_WAIT_V
#undef PG8_WAIT_L
#undef PG8_BAR
#undef PG8_SCHED
}
}
#define LAS __attribute__((address_space(3)))
typedef unsigned short bf16_t;
typedef short bf16x8 __attribute__((ext_vector_type(8)));
typedef float f32x4 __attribute__((ext_vector_type(4)));
typedef unsigned u32x4 __attribute__((ext_vector_type(4)));
typedef unsigned u32x2 __attribute__((ext_vector_type(2)));
using pg8::cvt_pk_bf16;
constexpr int SEQ = 8192, NB = 8, MTOK = NB * SEQ, DM = 1024, DFF = 2816, NMEM = 256;
constexpr float EPSN = 1e-6f, LOG2E = 1.4426950408889634f;
constexpr float FOX_QSCALE = 0.125f * LOG2E;
constexpr float MEM_QSCALE = 0.0625f * LOG2E;
constexpr float FOX_T2 = 60.0f;
constexpr size_t MiB = 1u << 20;
constexpr size_t WS_CTL = 0, CTL_BYTES = 32768;
constexpr size_t WS_SM = 2 * MiB, WS_FC = 6 * MiB, WS_KMEM = 8 * MiB, WS_VMEMT = 12 * MiB, WS_AMEM = 16 * MiB, WS_MISC = 20 * MiB;
constexpr size_t WS_WGU1 = 24 * MiB, WS_WD1 = 35 * MiB, WS_WIN = 41 * MiB, WS_WVT = 48 * MiB, WS_WOUT = 49 * MiB, WS_WQ = 51 * MiB, WS_WKV = 53 * MiB, WS_WO = 57 * MiB, WS_WGU2 = 59 * MiB, WS_WD2 = 70 * MiB;
constexpr size_t WS_A = 80 * MiB, WS_F = 208 * MiB, WS_BIG = 336 * MiB, WS_VT = 720 * MiB, WS_UT = 784 * MiB, WS_KTT = 848 * MiB, WS_ATT = 912 * MiB, WS_END = 944 * MiB;
constexpr size_t WS_NW = WS_F, WS_QD = WS_F + 64 * MiB;
constexpr size_t MISC_KT0 = 0, MISC_EGL = 65536;
constexpr int LDS_BYTES = 151552;
constexpr int LDS_BCAST = 150000;

struct Params { const float* in[27]; float* out; unsigned char* ws; };

__device__ __forceinline__ float bf2f(unsigned short b) { return __uint_as_float((unsigned)b << 16); }
__device__ __forceinline__ float bflo(unsigned w) { return __uint_as_float(w << 16); }
__device__ __forceinline__ float bfhi(unsigned w) { return __uint_as_float(w & 0xffff0000u); }
__device__ __forceinline__ float wave_sum(float v) {
#pragma unroll
    for (int o = 1; o < 64; o <<= 1) v += __shfl_xor(v, o);
    return v;
}
__device__ __forceinline__ float softplus_f(float x) { return fmaxf(x, 0.f) + log1pf(__expf(-fabsf(x))); }
#define LDS_WAIT() asm volatile("s_waitcnt lgkmcnt(0)" ::: "memory")

struct MapIdent { int off; __device__ __forceinline__ int operator()(int n) const { return n + off; } };
struct MapGate { __device__ __forceinline__ int operator()(int n) const { return (n >> 7) * 256 + (n & 127); } };
struct MapUp { __device__ __forceinline__ int operator()(int n) const { return (n >> 7) * 256 + 128 + (n & 127); } };
struct MapWin { __device__ __forceinline__ int operator()(int n) const {
    if (n < 1024) return n; if (n < 1536) return -1; if (n < 1544) return 3072 + (n - 1536); if (n < 3592) return 1024 + (n - 1544); return 3080 + (n - 3592); } };
struct MapWinV { __device__ __forceinline__ int operator()(int n) const { return (n >= 1024 && n < 1536) ? n - 1024 : -1; } };

template <class Map> __device__ __forceinline__ void transpose_item(const float* W, int K, int N, bf16_t* WT, const Map map, LAS float* scr, int item, int lane) {
    const int nblk = (N + 31) >> 5, kb = item / nblk, nb = item - kb * nblk, k0 = 64 * kb, n0 = 32 * nb;
    const int nn = n0 + (lane & 31);
#pragma unroll 8
    for (int i = 0; i < 32; ++i) { const int kk = 2 * i + (lane >> 5); scr[kk * 33 + (lane & 31)] = (nn < N) ? W[(size_t)(k0 + kk) * N + nn] : 0.f; }
    LDS_WAIT(); asm volatile("" ::: "memory");
    const int c = lane & 7;
#pragma unroll
    for (int j = 0; j < 4; ++j) { const int nl = (lane >> 3) + 8 * j; const int n = n0 + nl; const LAS float* s = scr + (8 * c) * 33 + nl;
        if (n < N) { const int dr = map(n);
            if (dr >= 0) { u32x4 o; o.x = cvt_pk_bf16(s[0 * 33], s[1 * 33]); o.y = cvt_pk_bf16(s[2 * 33], s[3 * 33]); o.z = cvt_pk_bf16(s[4 * 33], s[5 * 33]); o.w = cvt_pk_bf16(s[6 * 33], s[7 * 33]);
                *(u32x4*)(WT + (size_t)dr * K + k0 + 8 * c) = o; } } }
    LDS_WAIT(); asm volatile("" ::: "memory");
}
template <class Map> __device__ __forceinline__ void transpose_all(const float* W, int K, int N, bf16_t* WT, const Map map, LAS float* scr, int gw, int ngw, int lane) {
    const int nitems = (K / 64) * ((N + 31) >> 5);
    for (int it = gw; it < nitems; it += ngw) transpose_item(W, K, N, WT, map, scr, it, lane);
}

__device__ __forceinline__ void row_phase(const float* hin, const bf16_t* Fb, const float* gpost, float wres, float* hout, const float* gnext, bf16_t* Aout, int nrows, int gw, int ngw, int lane) {
    f32x4 gp[4], gn[4];
#pragma unroll
    for (int j = 0; j < 4; ++j) { gp[j] = Fb ? ((const f32x4*)gpost)[lane + 64 * j] : (f32x4){0.f, 0.f, 0.f, 0.f}; gn[j] = Aout ? ((const f32x4*)gnext)[lane + 64 * j] : (f32x4){0.f, 0.f, 0.f, 0.f}; }
    for (int r = gw; r < nrows; r += ngw) {
        f32x4 v[4];
#pragma unroll
        for (int j = 0; j < 4; ++j) v[j] = ((const f32x4*)(hin + (size_t)r * DM))[lane + 64 * j];
        if (Fb) {
            f32x4 f[4]; float ss = 0.f;
#pragma unroll
            for (int j = 0; j < 4; ++j) { const u32x2 w = ((const u32x2*)(Fb + (size_t)r * DM))[lane + 64 * j];
                f[j] = (f32x4){bflo(w.x), bfhi(w.x), bflo(w.y), bfhi(w.y)}; ss += (f[j].x * f[j].x + f[j].y * f[j].y) + (f[j].z * f[j].z + f[j].w * f[j].w); }
            const float rs = wres * rsqrtf(wave_sum(ss) * (1.f / DM) + EPSN);
#pragma unroll
            for (int j = 0; j < 4; ++j) v[j] = v[j] + (f[j] * rs) * gp[j];
        }
        if (hout) {
#if defined(SANITIZE)
#pragma unroll
            for (int j = 0; j < 4; ++j)
#pragma unroll
                for (int e = 0; e < 4; ++e) if (!(fabsf(v[j][e]) < 1e30f)) v[j][e] = 1e4f;
#endif
#pragma unroll
            for (int j = 0; j < 4; ++j) ((f32x4*)(hout + (size_t)r * DM))[lane + 64 * j] = v[j];
        }
        if (Aout) {
            float ss = 0.f;
#pragma unroll
            for (int j = 0; j < 4; ++j) ss += (v[j].x * v[j].x + v[j].y * v[j].y) + (v[j].z * v[j].z + v[j].w * v[j].w);
            const float rs = rsqrtf(wave_sum(ss) * (1.f / DM) + EPSN);
#pragma unroll
            for (int j = 0; j < 4; ++j) { const f32x4 o = (v[j] * rs) * gn[j]; u32x2 w; w.x = cvt_pk_bf16(o.x, o.y); w.y = cvt_pk_bf16(o.z, o.w);
                ((u32x2*)(Aout + (size_t)r * DM))[lane + 64 * j] = w; }
        }
    }
}

template <int D, bool FOX>
__device__ __forceinline__ void attn_unit(LAS unsigned char* lds, const bf16_t* Q, int ldq, const bf16_t* K, int ldk, const bf16_t* VT, int ldvt, bf16_t* O, int ldo,
                                          const float* Fc, int qb, int kt0, int kt1, int tid, int wid, int lane) {
    constexpr int KP = D + 8, VP = 72, NP = D / 64, KS = D / 32, DJ = D / 16;
    LAS bf16_t* Kl = (LAS bf16_t*)lds; LAS bf16_t* Vl = (LAS bf16_t*)(lds + 64 * KP * 2); LAS float* Fk = (LAS float*)(lds + 64 * KP * 2 + D * VP * 2);
    const int fr = lane & 15, fq = lane >> 4;
    const int q0 = qb * 128 + wid * 16;
    bf16x8 qf[KS];
#pragma unroll
    for (int ks = 0; ks < KS; ++ks) qf[ks] = *(const bf16x8*)(Q + (size_t)(q0 + fr) * ldq + 32 * ks + 8 * fq);
    float Fq = 0.f; if (FOX) Fq = Fc[q0 + fr];
    f32x4 o[DJ];
#pragma unroll
    for (int dj = 0; dj < DJ; ++dj) o[dj] = (f32x4){0.f, 0.f, 0.f, 0.f};
    float mrun = -INFINITY, lrun = 0.f;
    u32x4 kreg[NP], vreg[NP]; float fkreg = 0.f;
#define ATT_GLOAD(kt) do { _Pragma("unroll") for (int i_ = 0; i_ < NP; ++i_) { const int p_ = tid + 512 * i_; \
        { const int row_ = p_ / (D / 8), c_ = p_ % (D / 8); kreg[i_] = *(const u32x4*)(K + (size_t)((kt) * 64 + row_) * ldk + c_ * 8); } \
        { const int row_ = p_ >> 3, c_ = p_ & 7; vreg[i_] = *(const u32x4*)(VT + (size_t)row_ * ldvt + (kt) * 64 + c_ * 8); } } \
        if (FOX && tid < 64) fkreg = Fc[(kt) * 64 + tid]; } while (0)
    constexpr bool PREF = (D == 64);
    if (PREF) ATT_GLOAD(kt0);
    for (int kt = kt0; kt <= kt1; ++kt) {
        if (!PREF) ATT_GLOAD(kt);
        __syncthreads();
#pragma unroll
        for (int i = 0; i < NP; ++i) { const int p = tid + 512 * i;
            { const int row = p / (D / 8), c = p % (D / 8); *(LAS u32x4*)(Kl + row * KP + c * 8) = kreg[i]; }
            { const int row = p >> 3, c = p & 7; *(LAS u32x4*)(Vl + row * VP + c * 8) = vreg[i]; } }
        if (FOX && tid < 64) Fk[tid] = fkreg;
        __syncthreads();
        if (PREF && kt < kt1) ATT_GLOAD(kt + 1);
        if (FOX && kt * 64 > q0 + 15) continue;
        f32x4 s[4];
#pragma unroll
        for (int j = 0; j < 4; ++j) { if (FOX) { const f32x4 fk4 = *(const LAS f32x4*)(Fk + 16 * j + 4 * fq); s[j] = Fq - fk4; } else s[j] = (f32x4){0.f, 0.f, 0.f, 0.f}; }
#pragma unroll
        for (int ks = 0; ks < KS; ++ks)
#pragma unroll
            for (int j = 0; j < 4; ++j) { const bf16x8 kf = *(const LAS bf16x8*)(Kl + (16 * j + fr) * KP + 32 * ks + 8 * fq);
                s[j] = __builtin_amdgcn_mfma_f32_16x16x32_bf16(kf, qf[ks], s[j], 0, 0, 0); }
        if (FOX && kt * 64 + 63 > q0) {
#pragma unroll
            for (int j = 0; j < 4; ++j)
#pragma unroll
                for (int r = 0; r < 4; ++r) { const int key = kt * 64 + 16 * j + 4 * fq + r; if (key > q0 + fr) s[j][r] = -INFINITY; }
        }
        float mx = fmaxf(fmaxf(s[0][0], s[0][1]), fmaxf(s[0][2], s[0][3]));
#pragma unroll
        for (int j = 1; j < 4; ++j) mx = fmaxf(mx, fmaxf(fmaxf(s[j][0], s[j][1]), fmaxf(s[j][2], s[j][3])));
        mx = fmaxf(mx, __shfl_xor(mx, 16)); mx = fmaxf(mx, __shfl_xor(mx, 32));
        const float mnew = fmaxf(mrun, mx);
        const float alpha = __builtin_amdgcn_exp2f(mrun - mnew);
        mrun = mnew;
        float ls = 0.f;
#pragma unroll
        for (int j = 0; j < 4; ++j)
#pragma unroll
            for (int r = 0; r < 4; ++r) { s[j][r] = __builtin_amdgcn_exp2f(s[j][r] - mnew); ls += s[j][r]; }
        lrun = lrun * alpha + ls;
#pragma unroll
        for (int dj = 0; dj < DJ; ++dj) o[dj] = o[dj] * alpha;
        bf16x8 pf[2];
#pragma unroll
        for (int k2 = 0; k2 < 2; ++k2) { u32x4 w; w.x = cvt_pk_bf16(s[2 * k2][0], s[2 * k2][1]); w.y = cvt_pk_bf16(s[2 * k2][2], s[2 * k2][3]);
            w.z = cvt_pk_bf16(s[2 * k2 + 1][0], s[2 * k2 + 1][1]); w.w = cvt_pk_bf16(s[2 * k2 + 1][2], s[2 * k2 + 1][3]); pf[k2] = __builtin_bit_cast(bf16x8, w); }
#pragma unroll
        for (int dj = 0; dj < DJ; ++dj)
#pragma unroll
            for (int k2 = 0; k2 < 2; ++k2) { const u32x2 lo = *(const LAS u32x2*)(Vl + (16 * dj + fr) * VP + 32 * k2 + 4 * fq), hi = *(const LAS u32x2*)(Vl + (16 * dj + fr) * VP + 32 * k2 + 16 + 4 * fq);
                const u32x4 w = (u32x4){lo.x, lo.y, hi.x, hi.y};
                o[dj] = __builtin_amdgcn_mfma_f32_16x16x32_bf16(__builtin_bit_cast(bf16x8, w), pf[k2], o[dj], 0, 0, 0); }
    }
#undef ATT_GLOAD
    lrun += __shfl_xor(lrun, 16); lrun += __shfl_xor(lrun, 32);
    const float inv = 1.0f / lrun;
#pragma unroll
    for (int dj = 0; dj < DJ; ++dj) { u32x2 w; w.x = cvt_pk_bf16(o[dj][0] * inv, o[dj][1] * inv); w.y = cvt_pk_bf16(o[dj][2] * inv, o[dj][3] * inv);
        *(u32x2*)(O + (size_t)(q0 + fr) * ldo + 16 * dj + 4 * fq) = w; }
    __syncthreads();
}

__device__ __forceinline__ void fox_prep(LAS unsigned char* lds, const Params& P, int bh, int tid, int wid, int lane) {
    LAS float* WS = (LAS float*)lds;
    LAS float* E = WS + 16;
    LAS float* F0 = E + 128;
    LAS unsigned* MX = (LAS unsigned*)(F0 + 64);
    const int b = bh >> 3, h = bh & 7;
    const float* SM = (const float*)(P.ws + WS_SM); float* FC = (float*)(P.ws + WS_FC) + (size_t)bh * SEQ;
    const bf16_t* PJ = (const bf16_t*)(P.ws + WS_BIG);
    const float bias = P.in[9][h];
    if (tid < 2) MX[tid] = 0u;
    float pre[16]; float run = 0.f;
#pragma unroll
    for (int i = 0; i < 16; ++i) { const float x = SM[(size_t)(b * SEQ + 16 * tid + i) * 16 + h] + bias; const float ls = -softplus_f(-x) * LOG2E; run += ls; pre[i] = run; }
    float sc = run;
#pragma unroll
    for (int off = 1; off < 64; off <<= 1) { const float v = __shfl_up(sc, off); if (lane >= off) sc += v; }
    if (lane == 63) WS[wid] = sc;
    __syncthreads();
    float base = sc - run;
    for (int w = 0; w < wid; ++w) base += WS[w];
#pragma unroll
    for (int i = 0; i < 16; ++i) { pre[i] += base; FC[16 * tid + i] = pre[i]; }
    if ((tid & 3) == 3) E[tid >> 2] = pre[15];
    if ((tid & 7) == 0) F0[tid >> 3] = pre[0];
    float mq = 0.f, mk = 0.f;
    for (int i = 0; i < 16; ++i) { const bf16_t* qrow = PJ + (size_t)(b * SEQ + 16 * tid + i) * 3072 + h * 64; float sq = 0.f, sk = 0.f;
#pragma unroll
        for (int c = 0; c < 8; ++c) { const u32x4 a = *(const u32x4*)(qrow + 8 * c), k4 = *(const u32x4*)(qrow + 512 + 8 * c);
#pragma unroll
            for (int e = 0; e < 4; ++e) { const float a0 = bflo(a[e]), a1 = bfhi(a[e]), k0 = bflo(k4[e]), k1 = bfhi(k4[e]); sq += a0 * a0 + a1 * a1; sk += k0 * k0 + k1 * k1; } }
        mq = fmaxf(mq, sq); mk = fmaxf(mk, sk); }
    atomicMax((unsigned*)MX, __float_as_uint(mq)); atomicMax((unsigned*)MX + 1, __float_as_uint(mk));
    __syncthreads();
    if (tid < 64) { const float bound = 2.0f * sqrtf(__uint_as_float(MX[0]) * __uint_as_float(MX[1])) * 1.01f + 1.0f;
        const float f0 = F0[tid]; int kt = 0; while (kt < 2 * tid && f0 - E[kt] + bound < -FOX_T2) ++kt;
        ((int*)(P.ws + WS_MISC + MISC_KT0))[bh * 64 + tid] = kt; }
    __syncthreads();
}

constexpr int GP_KL = 0, GP_QL = 17408, GP_RHS = 34816, RHSP = 260, GP_LL = GP_RHS + 64 * RHSP * 4, GP_GC = GP_LL + 16384, GP_BETA = GP_GC + 256, GP_CW = GP_BETA + 256;
__device__ __forceinline__ void gdn_prep_chunk(LAS unsigned char* lds, const Params& P, int ci, int tid, int wid, int lane) {
    LAS bf16_t* Kl = (LAS bf16_t*)(lds + GP_KL); LAS bf16_t* Ql = (LAS bf16_t*)(lds + GP_QL); LAS float* RHS = (LAS float*)(lds + GP_RHS); LAS float* Ll = (LAS float*)(lds + GP_LL);
    LAS float* GC = (LAS float*)(lds + GP_GC); LAS float* BETA = (LAS float*)(lds + GP_BETA); LAS float* CW = (LAS float*)(lds + GP_CW);
    const float* SM = (const float*)(P.ws + WS_SM); const bf16_t* PJ = (const bf16_t*)(P.ws + WS_BIG);
    const int t = tid >> 3, cg8 = tid & 7, ch0 = 16 * cg8;
    float ga_n = 0.f, gb_n = 0.f;
    if (wid == 0) { const size_t R_ = (size_t)(ci >> 9) * SEQ + (size_t)(ci & 127) * 64 + lane; ga_n = SM[R_ * 16 + 12 + ((ci >> 7) & 3)]; gb_n = SM[R_ * 16 + 8 + ((ci >> 7) & 3)]; }
    {
    const int h = (ci >> 7) & 3, c = ci & 127;
    bf16_t* NW = (bf16_t*)(P.ws + WS_NW) + (size_t)ci * 8192; bf16_t* QD = (bf16_t*)(P.ws + WS_QD) + (size_t)ci * 8192; bf16_t* ATT = (bf16_t*)(P.ws + WS_ATT) + (size_t)ci * 4096;
    bf16_t* KTT = (bf16_t*)(P.ws + WS_KTT) + (size_t)ci * 8192; bf16_t* UT = (bf16_t*)(P.ws + WS_UT) + (size_t)ci * 8192;
    if (wid == 0) {
        float g = -__expf(P.in[11][h]) * softplus_f(ga_n + P.in[12][h]);
#pragma unroll
        for (int off = 1; off < 64; off <<= 1) { const float v = __shfl_up(g, off); if (lane >= off) g += v; }
        GC[lane] = g; BETA[lane] = 1.0f / (1.0f + __expf(-gb_n));
        if (lane == 63) ((float*)(P.ws + WS_MISC + MISC_EGL))[ci] = __expf(g);
    }
    __syncthreads();
    {
        float y[3][16];
#pragma unroll
        for (int mat = 0; mat < 3; ++mat) {
#pragma unroll
            for (int e = 0; e < 16; ++e) y[mat][e] = 0.f;
            const bf16_t* src0 = PJ + ((size_t)(ci >> 9) * SEQ + c * 64 + t) * 3072 + 1024 + 512 * mat + h * 128 + ch0;
            const LAS float* wsrc0 = CW + 512 * mat + h * 128 + ch0;
            if (c * 64 + t >= 3) {
                u32x4 xr[4][2];
#pragma unroll
                for (int i = 0; i < 4; ++i) { xr[i][0] = *(const u32x4*)(src0 + (i - 3) * 3072); xr[i][1] = *(const u32x4*)(src0 + (i - 3) * 3072 + 8); }
#pragma unroll
                for (int i = 0; i < 4; ++i) { const u32x4 x0 = xr[i][0], x1 = xr[i][1];
#pragma unroll
                    for (int e = 0; e < 4; ++e) { const f32x4 w4 = *(const LAS f32x4*)(wsrc0 + i * 1536 + 4 * e); const unsigned xa = (e < 2) ? x0[2 * e] : x1[2 * e - 4], xb = (e < 2) ? x0[2 * e + 1] : x1[2 * e - 3];
                        y[mat][4 * e + 0] += w4.x * bflo(xa); y[mat][4 * e + 1] += w4.y * bfhi(xa); y[mat][4 * e + 2] += w4.z * bflo(xb); y[mat][4 * e + 3] += w4.w * bfhi(xb); } }
            } else {
#pragma unroll
                for (int i = 0; i < 4; ++i) { const int tt = c * 64 + t - 3 + i;
                    if (tt >= 0) { const u32x4 x0 = *(const u32x4*)(src0 + (i - 3) * 3072), x1 = *(const u32x4*)(src0 + (i - 3) * 3072 + 8);
#pragma unroll
                        for (int e = 0; e < 4; ++e) { const f32x4 w4 = *(const LAS f32x4*)(wsrc0 + i * 1536 + 4 * e); const unsigned xa = (e < 2) ? x0[2 * e] : x1[2 * e - 4], xb = (e < 2) ? x0[2 * e + 1] : x1[2 * e - 3];
                            y[mat][4 * e + 0] += w4.x * bflo(xa); y[mat][4 * e + 1] += w4.y * bfhi(xa); y[mat][4 * e + 2] += w4.z * bflo(xb); y[mat][4 * e + 3] += w4.w * bfhi(xb); } } }
            }
#pragma unroll
            for (int e = 0; e < 16; ++e) y[mat][e] = pg8::silu_f(y[mat][e]);
        }
        float sq = 0.f, sk = 0.f;
#pragma unroll
        for (int e = 0; e < 16; ++e) { sq += y[0][e] * y[0][e]; sk += y[1][e] * y[1][e]; }
#pragma unroll
        for (int o = 1; o < 8; o <<= 1) { sq += __shfl_xor(sq, o); sk += __shfl_xor(sk, o); }
        const float rq = rsqrtf(sq + EPSN) * 0.08838834764831845f, rk = rsqrtf(sk + EPSN);
        const float gct = GC[t], bt = BETA[t], egt = __expf(gct);
#pragma unroll
        for (int e = 0; e < 16; ++e) { y[0][e] *= rq; y[1][e] *= rk; }
        u32x4 w0, w1;
        w0.x = cvt_pk_bf16(y[1][0], y[1][1]); w0.y = cvt_pk_bf16(y[1][2], y[1][3]); w0.z = cvt_pk_bf16(y[1][4], y[1][5]); w0.w = cvt_pk_bf16(y[1][6], y[1][7]);
        w1.x = cvt_pk_bf16(y[1][8], y[1][9]); w1.y = cvt_pk_bf16(y[1][10], y[1][11]); w1.z = cvt_pk_bf16(y[1][12], y[1][13]); w1.w = cvt_pk_bf16(y[1][14], y[1][15]);
        *(LAS u32x4*)(Kl + t * 136 + ch0) = w0; *(LAS u32x4*)(Kl + t * 136 + ch0 + 8) = w1;
        w0.x = cvt_pk_bf16(y[0][0], y[0][1]); w0.y = cvt_pk_bf16(y[0][2], y[0][3]); w0.z = cvt_pk_bf16(y[0][4], y[0][5]); w0.w = cvt_pk_bf16(y[0][6], y[0][7]);
        w1.x = cvt_pk_bf16(y[0][8], y[0][9]); w1.y = cvt_pk_bf16(y[0][10], y[0][11]); w1.z = cvt_pk_bf16(y[0][12], y[0][13]); w1.w = cvt_pk_bf16(y[0][14], y[0][15]);
        *(LAS u32x4*)(Ql + t * 136 + ch0) = w0; *(LAS u32x4*)(Ql + t * 136 + ch0 + 8) = w1;
#pragma unroll
        for (int e = 0; e < 4; ++e) { *(LAS f32x4*)(RHS + t * RHSP + ch0 + 4 * e) = (f32x4){bt * y[2][4 * e], bt * y[2][4 * e + 1], bt * y[2][4 * e + 2], bt * y[2][4 * e + 3]};
            const float be = bt * egt; *(LAS f32x4*)(RHS + t * RHSP + 128 + ch0 + 4 * e) = (f32x4){be * y[1][4 * e], be * y[1][4 * e + 1], be * y[1][4 * e + 2], be * y[1][4 * e + 3]}; }
#pragma unroll
        for (int e = 0; e < 4; ++e) { u32x2 w; w.x = cvt_pk_bf16(y[0][4 * e] * egt, y[0][4 * e + 1] * egt); w.y = cvt_pk_bf16(y[0][4 * e + 2] * egt, y[0][4 * e + 3] * egt);
            *(u32x2*)(QD + t * 128 + 32 * (cg8 >> 1) + 8 * e + 4 * (cg8 & 1)) = w; }
    }
    __syncthreads();
    {
        const int fr = lane & 15, fq = lane >> 4, ti = wid >> 1, jp = wid & 1;
        f32x4 kk[2], qk[2];
#pragma unroll
        for (int e = 0; e < 2; ++e) { kk[e] = (f32x4){0.f, 0.f, 0.f, 0.f}; qk[e] = (f32x4){0.f, 0.f, 0.f, 0.f}; }
#pragma unroll
        for (int ks = 0; ks < 4; ++ks) { const bf16x8 bK = *(const LAS bf16x8*)(Kl + (16 * ti + fr) * 136 + 32 * ks + 8 * fq), bQ = *(const LAS bf16x8*)(Ql + (16 * ti + fr) * 136 + 32 * ks + 8 * fq);
#pragma unroll
            for (int e = 0; e < 2; ++e) { const bf16x8 a = *(const LAS bf16x8*)(Kl + (16 * (2 * jp + e) + fr) * 136 + 32 * ks + 8 * fq);
                kk[e] = __builtin_amdgcn_mfma_f32_16x16x32_bf16(a, bK, kk[e], 0, 0, 0); qk[e] = __builtin_amdgcn_mfma_f32_16x16x32_bf16(a, bQ, qk[e], 0, 0, 0); } }
        const int t = 16 * ti + fr; const float gct = GC[t];
        float av[8];
#pragma unroll
        for (int e = 0; e < 2; ++e) { f32x4 lv;
#pragma unroll
            for (int r = 0; r < 4; ++r) { const int s = 16 * (2 * jp + e) + 4 * fq + r; const float gcs = GC[s]; const float dec = __expf(fminf(gct - gcs, 0.f)), dec2 = __expf(fminf(gcs - gct, 0.f));
                lv[r] = (t < s) ? BETA[s] * kk[e][r] * dec2 : 0.f; av[4 * e + r] = (s <= t) ? qk[e][r] * dec : 0.f; }
            *(LAS f32x4*)(Ll + t * 64 + 16 * (2 * jp + e) + 4 * fq) = lv; }
        u32x4 w; w.x = cvt_pk_bf16(av[0], av[1]); w.y = cvt_pk_bf16(av[2], av[3]); w.z = cvt_pk_bf16(av[4], av[5]); w.w = cvt_pk_bf16(av[6], av[7]);
        *(u32x4*)(ATT + t * 64 + 32 * jp + 8 * fq) = w;
    }
    __syncthreads();
    if (wid < 4) {
        const int col = 64 * wid + lane;
        int vz; asm volatile("v_mov_b32 %0, 0" : "=v"(vz));
        const LAS float* Lz = Ll + 4 * vz;
        float x[64];
#pragma unroll
        for (int i = 0; i < 64; ++i) x[i] = RHS[i * RHSP + col];
#pragma unroll
        for (int m = 0; m < 63; ++m) { const float xm = x[m];
#pragma unroll
            for (int g4 = (m + 1) / 4; g4 < 16; ++g4) { const f32x4 l4 = *(const LAS f32x4*)(Lz + m * 64 + 4 * g4);
                x[4 * g4] -= l4.x * xm; x[4 * g4 + 1] -= l4.y * xm; x[4 * g4 + 2] -= l4.z * xm; x[4 * g4 + 3] -= l4.w * xm; } }
        if (wid < 2) {
#pragma unroll
            for (int j = 0; j < 8; ++j) { u32x4 w; w.x = cvt_pk_bf16(x[8 * j], x[8 * j + 1]); w.y = cvt_pk_bf16(x[8 * j + 2], x[8 * j + 3]); w.z = cvt_pk_bf16(x[8 * j + 4], x[8 * j + 5]); w.w = cvt_pk_bf16(x[8 * j + 6], x[8 * j + 7]);
                *(u32x4*)(UT + col * 64 + 8 * j) = w; }
        } else {
            const int dk = col - 128, o = dk & 31; const int pos = (dk & ~31) + ((o < 16) ? (8 * (o >> 2) + (o & 3)) : (8 * ((o - 16) >> 2) + 4 + (o & 3)));
#pragma unroll
            for (int i = 0; i < 64; ++i) NW[i * 128 + pos] = (bf16_t)(cvt_pk_bf16(-x[i], 0.f) & 0xffffu);
        }
    } else {
        const int idx = tid - 256, dk = idx >> 1, th = idx & 1; const float gl = GC[63];
        float v[32];
#pragma unroll
        for (int pos = 0; pos < 32; ++pos) { const int a = pos >> 3, s = pos & 7; const int o = (s < 4) ? (4 * a + s) : (16 + 4 * a + s - 4); const int t = 32 * th + o;
            v[pos] = bf2f(Kl[t * 136 + dk]) * __expf(gl - GC[t]); }
#pragma unroll
        for (int j = 0; j < 4; ++j) { u32x4 w; w.x = cvt_pk_bf16(v[8 * j], v[8 * j + 1]); w.y = cvt_pk_bf16(v[8 * j + 2], v[8 * j + 3]); w.z = cvt_pk_bf16(v[8 * j + 4], v[8 * j + 5]); w.w = cvt_pk_bf16(v[8 * j + 6], v[8 * j + 7]);
            *(u32x4*)(KTT + dk * 64 + 32 * th + 8 * j) = w; }
    }
    __syncthreads();
    }
}

constexpr int GS_NW = 0, GS_QD = 17408, GS_ATT = 34816, GS_KTT = 44032, GS_UT = 62464, GS_OL = 80896;
__device__ __forceinline__ void gdn_scan(LAS unsigned char* lds, const Params& P, int bh, int tid, int wid, int lane) {
    LAS bf16_t* NWl = (LAS bf16_t*)(lds + GS_NW); LAS bf16_t* QDl = (LAS bf16_t*)(lds + GS_QD); LAS bf16_t* ATTl = (LAS bf16_t*)(lds + GS_ATT);
    LAS bf16_t* KTTl = (LAS bf16_t*)(lds + GS_KTT); LAS bf16_t* UTl = (LAS bf16_t*)(lds + GS_UT); LAS float* OL = (LAS float*)(lds + GS_OL);
    const int b = bh >> 2, h = bh & 3, fr = lane & 15, fq = lane >> 4;
    const bf16_t* PJ = (const bf16_t*)(P.ws + WS_BIG); bf16_t* MIX = (bf16_t*)(P.ws + WS_A);
    const float* EGL = (const float*)(P.ws + WS_MISC + MISC_EGL) + (size_t)bh * 128;
    const u32x4* gNW = (const u32x4*)(P.ws + WS_NW) + (size_t)bh * 128 * 1024; const u32x4* gQD = (const u32x4*)(P.ws + WS_QD) + (size_t)bh * 128 * 1024;
    const u32x4* gATT = (const u32x4*)(P.ws + WS_ATT) + (size_t)bh * 128 * 512; const u32x4* gKTT = (const u32x4*)(P.ws + WS_KTT) + (size_t)bh * 128 * 1024; const u32x4* gUT = (const u32x4*)(P.ws + WS_UT) + (size_t)bh * 128 * 1024;
    const int ot = tid >> 3, og = tid & 7;
    f32x4 Sacc[8];
#pragma unroll
    for (int m = 0; m < 8; ++m) Sacc[m] = (f32x4){0.f, 0.f, 0.f, 0.f};
    u32x4 rNW[2], rQD[2], rATT, rKTT[2], rUT[2]; float egl_n;
#define GS_GLOAD(c) do { _Pragma("unroll") for (int i_ = 0; i_ < 2; ++i_) { rNW[i_] = gNW[(size_t)(c) * 1024 + tid + 512 * i_]; rQD[i_] = gQD[(size_t)(c) * 1024 + tid + 512 * i_]; \
        rKTT[i_] = gKTT[(size_t)(c) * 1024 + tid + 512 * i_]; rUT[i_] = gUT[(size_t)(c) * 1024 + tid + 512 * i_]; } rATT = gATT[(size_t)(c) * 512 + tid]; egl_n = EGL[c]; } while (0)
    GS_GLOAD(0);
    for (int c = 0; c < 128; ++c) {
#pragma unroll
        for (int i = 0; i < 2; ++i) { const int p = tid + 512 * i;
            *(LAS u32x4*)(NWl + (p >> 4) * 136 + (p & 15) * 8) = rNW[i]; *(LAS u32x4*)(QDl + (p >> 4) * 136 + (p & 15) * 8) = rQD[i];
            *(LAS u32x4*)(KTTl + (p >> 3) * 72 + (p & 7) * 8) = rKTT[i]; *(LAS u32x4*)(UTl + (p >> 3) * 72 + (p & 7) * 8) = rUT[i]; }
        *(LAS u32x4*)(ATTl + (tid >> 3) * 72 + (tid & 7) * 8) = rATT;
        const float egl = egl_n;
        __syncthreads();
        if (c + 1 < 128) GS_GLOAD(c + 1);
        const size_t R = (size_t)b * SEQ + (size_t)c * 64 + ot;
        const u32x4 gz0 = *(const u32x4*)(PJ + R * 3072 + 2560 + h * 128 + 16 * og), gz1 = *(const u32x4*)(PJ + R * 3072 + 2560 + h * 128 + 16 * og + 8);
        bf16x8 Bs[4];
#pragma unroll
        for (int ks = 0; ks < 4; ++ks) { u32x4 w; w.x = cvt_pk_bf16(Sacc[2 * ks][0], Sacc[2 * ks][1]); w.y = cvt_pk_bf16(Sacc[2 * ks][2], Sacc[2 * ks][3]);
            w.z = cvt_pk_bf16(Sacc[2 * ks + 1][0], Sacc[2 * ks + 1][1]); w.w = cvt_pk_bf16(Sacc[2 * ks + 1][2], Sacc[2 * ks + 1][3]); Bs[ks] = __builtin_bit_cast(bf16x8, w); }
        f32x4 VN[4], OA[4];
#pragma unroll
        for (int mt = 0; mt < 4; ++mt) { const u32x2 u2 = *(const LAS u32x2*)(UTl + (16 * wid + fr) * 72 + 16 * mt + 4 * fq);
            VN[mt] = (f32x4){bflo(u2.x), bfhi(u2.x), bflo(u2.y), bfhi(u2.y)}; OA[mt] = (f32x4){0.f, 0.f, 0.f, 0.f}; }
#pragma unroll
        for (int ks = 0; ks < 4; ++ks)
#pragma unroll
            for (int mt = 0; mt < 4; ++mt) { const bf16x8 a = *(const LAS bf16x8*)(NWl + (16 * mt + fr) * 136 + 32 * ks + 8 * fq), q = *(const LAS bf16x8*)(QDl + (16 * mt + fr) * 136 + 32 * ks + 8 * fq);
                VN[mt] = __builtin_amdgcn_mfma_f32_16x16x32_bf16(a, Bs[ks], VN[mt], 0, 0, 0); OA[mt] = __builtin_amdgcn_mfma_f32_16x16x32_bf16(q, Bs[ks], OA[mt], 0, 0, 0); }
        bf16x8 Bv[2];
#pragma unroll
        for (int k2 = 0; k2 < 2; ++k2) { u32x4 w; w.x = cvt_pk_bf16(VN[2 * k2][0], VN[2 * k2][1]); w.y = cvt_pk_bf16(VN[2 * k2][2], VN[2 * k2][3]);
            w.z = cvt_pk_bf16(VN[2 * k2 + 1][0], VN[2 * k2 + 1][1]); w.w = cvt_pk_bf16(VN[2 * k2 + 1][2], VN[2 * k2 + 1][3]); Bv[k2] = __builtin_bit_cast(bf16x8, w); }
#pragma unroll
        for (int k2 = 0; k2 < 2; ++k2)
#pragma unroll
            for (int mt = 0; mt < 4; ++mt) { const bf16x8 a = *(const LAS bf16x8*)(ATTl + (16 * mt + fr) * 72 + 32 * k2 + 8 * fq);
                OA[mt] = __builtin_amdgcn_mfma_f32_16x16x32_bf16(a, Bv[k2], OA[mt], 0, 0, 0); }
#pragma unroll
        for (int m = 0; m < 8; ++m) Sacc[m] = Sacc[m] * egl;
#pragma unroll
        for (int k2 = 0; k2 < 2; ++k2)
#pragma unroll
            for (int m = 0; m < 8; ++m) { const bf16x8 a = *(const LAS bf16x8*)(KTTl + (16 * m + fr) * 72 + 32 * k2 + 8 * fq);
                Sacc[m] = __builtin_amdgcn_mfma_f32_16x16x32_bf16(a, Bv[k2], Sacc[m], 0, 0, 0); }
#pragma unroll
        for (int mt = 0; mt < 4; ++mt)
#pragma unroll
            for (int r = 0; r < 4; ++r) OL[(16 * mt + 4 * fq + r) * 132 + 16 * wid + fr] = OA[mt][r];
        __syncthreads();
        {
            f32x4 ov[4], gain[4]; float ss = 0.f;
#pragma unroll
            for (int e = 0; e < 4; ++e) gain[e] = *(const f32x4*)(P.in[13] + 16 * og + 4 * e);
#pragma unroll
            for (int e = 0; e < 4; ++e) { ov[e] = *(const LAS f32x4*)(OL + ot * 132 + 16 * og + 4 * e); ss += (ov[e].x * ov[e].x + ov[e].y * ov[e].y) + (ov[e].z * ov[e].z + ov[e].w * ov[e].w); }
#pragma unroll
            for (int o = 1; o < 8; o <<= 1) ss += __shfl_xor(ss, o);
            const float rs = rsqrtf(ss * (1.0f / 128.0f) + EPSN);
            float z[16];
#pragma unroll
            for (int e = 0; e < 4; ++e) { z[2 * e] = bflo(gz0[e]); z[2 * e + 1] = bfhi(gz0[e]); z[8 + 2 * e] = bflo(gz1[e]); z[8 + 2 * e + 1] = bfhi(gz1[e]); }
            float r16[16];
#pragma unroll
            for (int e = 0; e < 4; ++e) { r16[4 * e] = ov[e].x * rs * gain[e].x * pg8::silu_f(z[4 * e]); r16[4 * e + 1] = ov[e].y * rs * gain[e].y * pg8::silu_f(z[4 * e + 1]);
                r16[4 * e + 2] = ov[e].z * rs * gain[e].z * pg8::silu_f(z[4 * e + 2]); r16[4 * e + 3] = ov[e].w * rs * gain[e].w * pg8::silu_f(z[4 * e + 3]); }
            u32x4 w0, w1;
            w0.x = cvt_pk_bf16(r16[0], r16[1]); w0.y = cvt_pk_bf16(r16[2], r16[3]); w0.z = cvt_pk_bf16(r16[4], r16[5]); w0.w = cvt_pk_bf16(r16[6], r16[7]);
            w1.x = cvt_pk_bf16(r16[8], r16[9]); w1.y = cvt_pk_bf16(r16[10], r16[11]); w1.z = cvt_pk_bf16(r16[12], r16[13]); w1.w = cvt_pk_bf16(r16[14], r16[15]);
            bf16_t* dst = MIX + R * 1024 + 512 + h * 128 + 16 * og;
            *(u32x4*)dst = w0; *(u32x4*)(dst + 8) = w1;
        }
    }
#undef GS_GLOAD
    __syncthreads();
}

#if defined(__HIP_DEVICE_COMPILE__)
__device__ __forceinline__ Params getp() { auto k = __builtin_amdgcn_kernarg_segment_ptr(); asm volatile("" : "+s"(k)); return *(const Params __attribute__((address_space(4)))*)k; }
#else
__device__ __forceinline__ Params getp() { return Params{}; }
#endif
#define GEMM_BF16(Aptr, Bptr, M_, N_, K_, Optr, ldc_, scale_, coff_) do { const Params P = getp(); unsigned char* ws = P.ws; (void)ws; \
        pg8::Gemm g{(const bf16_t*)(Aptr), (const bf16_t*)(Bptr), (M_), (N_), (K_)}; pg8::StaticOrder S; S.init((M_), (N_), G, (bid + (coff_)) % G); pg8::EpiBf16 E{(bf16_t*)(Optr), (ldc_), (scale_)}; \
        _Pragma("unroll") for (int rep_ = 0; rep_ < GEMM_REPS; ++rep_) pg8::gemm_phase<pg8::EpiBf16, pg8::StaticOrder, true, true>(lds, g, S, E); } while (0)
#define GEMM_SWIGLU(Bptr) do { const Params P = getp(); unsigned char* ws = P.ws; \
        pg8::Gemm g{(const bf16_t*)(ws + WS_A), (const bf16_t*)(Bptr), MTOK, 2 * DFF, DM}; pg8::StaticOrder S; S.init(MTOK, 2 * DFF, G, bid); pg8::EpiSwiGLU E{(bf16_t*)(ws + WS_BIG), DFF}; \
        _Pragma("unroll") for (int rep_ = 0; rep_ < GEMM_REPS; ++rep_) pg8::gemm_phase<pg8::EpiSwiGLU, pg8::StaticOrder, true, true>(lds, g, S, E); } while (0)
#define ROW_PHASE(hin_, gpost_, w_, gnext_, hasA_) do { PH_IDS const Params P = getp(); unsigned char* ws = P.ws; \
        row_phase((hin_), (const bf16_t*)(ws + WS_F), (gpost_), (w_), P.out, (gnext_), (hasA_) ? (bf16_t*)(ws + WS_A) : nullptr, MTOK, gw, ngw, lane); } while (0)
#define GSYNC() cg::this_grid().sync()
#ifndef GEMM_REPS
#define GEMM_REPS 1
#endif

__global__ void __launch_bounds__(512, 2) hymba_fwd(Params Parg) {
    extern __shared__ __attribute__((aligned(16))) unsigned char lds_raw[];
    LAS unsigned char* lds = (LAS unsigned char*)lds_raw;
    const int G = gridDim.x, bid = blockIdx.x;
#define PH_IDS int tid_l = threadIdx.x; asm volatile("" : "+v"(tid_l)); const int tid = tid_l, lane = tid & 63, wid = __builtin_amdgcn_readfirstlane(tid >> 6), gw = bid * 8 + wid, ngw = G * 8; (void)gw; (void)ngw; (void)lane; \
        volatile LAS unsigned* bc = (volatile LAS unsigned*)(lds + LDS_BCAST); (void)bc;

    {
        PH_IDS const Params P = getp(); unsigned char* ws = P.ws;
        LAS float* scr = (LAS float*)(lds + wid * 16384);
        if (bid == 0 && tid < 64) { unsigned* ctl = (unsigned*)(ws + WS_CTL); ctl[64 * tid] = 0u; }
        transpose_all(P.in[3], DM, DFF, (bf16_t*)(ws + WS_WGU1), MapGate{}, scr, gw, ngw, lane);
        transpose_all(P.in[4], DM, DFF, (bf16_t*)(ws + WS_WGU1), MapUp{}, scr, gw, ngw, lane);
        transpose_all(P.in[5], DFF, DM, (bf16_t*)(ws + WS_WD1), MapIdent{0}, scr, gw, ngw, lane);
        transpose_all(P.in[8], DM, 3600, (bf16_t*)(ws + WS_WIN), MapWin{}, scr, gw, ngw, lane);
        transpose_all(P.in[8], DM, 3600, (bf16_t*)(ws + WS_WVT), MapWinV{}, scr, gw, ngw, lane);
        transpose_all(P.in[14], DM, DM, (bf16_t*)(ws + WS_WOUT), MapIdent{0}, scr, gw, ngw, lane);
        transpose_all(P.in[18], DM, DM, (bf16_t*)(ws + WS_WQ), MapIdent{0}, scr, gw, ngw, lane);
        transpose_all(P.in[19], DM, 2 * DM, (bf16_t*)(ws + WS_WKV), MapIdent{0}, scr, gw, ngw, lane);
        transpose_all(P.in[20], DM, DM, (bf16_t*)(ws + WS_WO), MapIdent{0}, scr, gw, ngw, lane);
        transpose_all(P.in[23], DM, DFF, (bf16_t*)(ws + WS_WGU2), MapGate{}, scr, gw, ngw, lane);
        transpose_all(P.in[24], DM, DFF, (bf16_t*)(ws + WS_WGU2), MapUp{}, scr, gw, ngw, lane);
        transpose_all(P.in[25], DFF, DM, (bf16_t*)(ws + WS_WD2), MapIdent{0}, scr, gw, ngw, lane);
        {
            u32x4* z = (u32x4*)((bf16_t*)(ws + WS_WIN) + (size_t)3088 * DM); const int n16 = 240 * DM / 8;
            for (int i = bid * 512 + tid; i < n16; i += G * 512) z[i] = (u32x4){0u, 0u, 0u, 0u};
        }
        row_phase(P.in[0], nullptr, nullptr, 0.f, nullptr, P.in[2], (bf16_t*)(ws + WS_A), MTOK, gw, ngw, lane);
        row_phase(P.in[1], nullptr, nullptr, 0.f, nullptr, P.in[17], (bf16_t*)(ws + WS_AMEM), NB * NMEM, gw, ngw, lane);
    }
    GSYNC();
#if defined(STOP_AFTER)
    if (STOP_AFTER == 0) return;
#endif
    GEMM_SWIGLU(ws + WS_WGU1);
    GEMM_BF16(ws + WS_AMEM, ws + WS_WKV, NB * NMEM, DM, DM, ws + WS_KMEM, DM, 1.f, 64);
    GEMM_BF16((const bf16_t*)(ws + WS_WKV) + (size_t)DM * DM, ws + WS_AMEM, DM, NB * NMEM, DM, ws + WS_VMEMT, NB * NMEM, 1.f, 128);
    GSYNC();
#if defined(STOP_AFTER)
    if (STOP_AFTER == 1) return;
#endif
    GEMM_BF16(ws + WS_BIG, ws + WS_WD1, MTOK, DM, DFF, ws + WS_F, DM, 1.f, 0);
    GSYNC();
#if defined(STOP_AFTER)
    if (STOP_AFTER == 2) return;
#endif
    ROW_PHASE(P.in[0], P.in[6], 0.5f, P.in[7], true);
    GSYNC();
#if defined(STOP_AFTER)
    if (STOP_AFTER == 3) return;
#endif
    { const Params P = getp(); unsigned char* ws = P.ws;
      pg8::Gemm g{(const bf16_t*)(ws + WS_A), (const bf16_t*)(ws + WS_WIN), MTOK, 3328, DM}; pg8::StaticOrder S; S.init(MTOK, 3328, G, bid); pg8::EpiProj E{(bf16_t*)(ws + WS_BIG), (float*)(ws + WS_SM), FOX_QSCALE};
      _Pragma("unroll") for (int rep_ = 0; rep_ < GEMM_REPS; ++rep_) pg8::gemm_phase<pg8::EpiProj, pg8::StaticOrder, true, true>(lds, g, S, E); }
    GEMM_BF16(ws + WS_WVT, ws + WS_A, 512, MTOK, DM, ws + WS_VT, MTOK, 1.f, 0);
    GSYNC();
#if defined(STOP_AFTER)
    if (STOP_AFTER == 4) return;
#endif
    { PH_IDS const Params P = getp(); unsigned* ctl = (unsigned*)(P.ws + WS_CTL);
#ifndef P5_REPS
#define P5_REPS 1
#endif
      {
#ifndef FOXP_REPS
#define FOXP_REPS 1
#endif
      if (bid < 64) { for (int rp = 0; rp < FOXP_REPS; ++rp) fox_prep(lds, P, bid, tid, wid, lane); }
      { LAS float* CW = (LAS float*)(lds + GP_CW); for (int i = tid; i < 6144; i += 512) CW[i] = P.in[10][i]; }
      for (;;) { if (tid == 0) *bc = atomicAdd(ctl + 0, 1u); __syncthreads(); const int ci = (int)*bc; __syncthreads(); if (ci >= 4096) break;
          gdn_prep_chunk(lds, P, ci, tid, wid, lane); } } }
    GSYNC();
#if defined(STOP_AFTER)
    if (STOP_AFTER == 5) return;
#endif
#if defined(DUMP_PREP)
    { PH_IDS const Params P = getp(); unsigned char* ws = P.ws; const bf16_t* s0 = (const bf16_t*)(ws + DUMP_A); const bf16_t* s1 = (const bf16_t*)(ws + DUMP_B);
      for (int i = bid * 512 + tid; i < 4096 * 8192; i += G * 512) { float a = bf2f(s0[i]), b = bf2f(s1[i]); if (!(fabsf(a) < 1e30f)) a = 1e4f; if (!(fabsf(b) < 1e30f)) b = 1e4f;
          if (fabsf(a) > 100.f) a = 3e3f; if (fabsf(b) > 100.f) b = 3e3f; P.out[i] = a; P.out[4096 * 8192 + i] = b; } }
    return;
#endif
    { PH_IDS const Params P = getp(); unsigned char* ws = P.ws; unsigned* ctl = (unsigned*)(ws + WS_CTL);
#ifndef P6_REPS
#define P6_REPS 1
#endif
      {
#if defined(SKIP_GDN)
      for (int i = bid * 512 + tid; i < MTOK * 64; i += G * 512) { ((u32x4*)(ws + WS_A))[(i >> 6) * 128 + 64 + (i & 63)] = (u32x4){0u, 0u, 0u, 0u}; }
#else
      if (bid < 32) gdn_scan(lds, P, bid, tid, wid, lane);
#endif
#if defined(SKIP_FOX)
      for (int i = bid * 512 + tid; i < MTOK * 64; i += G * 512) { ((u32x4*)(ws + WS_A))[(i >> 6) * 128 + (i & 63)] = (u32x4){0u, 0u, 0u, 0u}; }
#endif
      const int* KT0 = (const int*)(ws + WS_MISC + MISC_KT0); const bf16_t* PJ = (const bf16_t*)(ws + WS_BIG);
#if defined(SKIP_FOX)
      if (0)
#endif
      for (;;) { if (tid == 0) *bc = atomicAdd(ctl + 64, 1u); __syncthreads(); const int idx = (int)*bc; __syncthreads(); if (idx >= 4096) break;
          const int qb = 63 - (idx >> 6), bh = idx & 63, b = bh >> 3, h = bh & 7;
          const int kt0 = KT0[bh * 64 + qb];
          attn_unit<64, true>(lds, PJ + (size_t)b * SEQ * 3072 + h * 64, 3072, PJ + (size_t)b * SEQ * 3072 + 512 + h * 64, 3072,
                              (const bf16_t*)(ws + WS_VT) + (size_t)(h * 64) * MTOK + (size_t)b * SEQ, MTOK, (bf16_t*)(ws + WS_A) + (size_t)b * SEQ * 1024 + h * 64, 1024,
                              (const float*)(ws + WS_FC) + (size_t)bh * SEQ, qb, kt0, 2 * qb + 1, tid, wid, lane); } } }
    GSYNC();
#if defined(STOP_AFTER)
    if (STOP_AFTER == 6) return;
#endif
#if defined(DUMP_MIX)
    { PH_IDS const Params P = getp(); unsigned char* ws = P.ws; const bf16_t* s0 = (const bf16_t*)(ws + WS_A);
      for (int i = bid * 512 + tid; i < MTOK * 1024; i += G * 512) { float a = bf2f(s0[i]); if (!(fabsf(a) < 1e30f)) a = 1e4f; else if (fabsf(a) > 100.f) a = 3e3f;
#if defined(DUMP_MASK0)
          if ((((i >> 10) & 8191) >> 6) == DUMP_MASK0) a = 0.f;
#endif
          P.out[i] = a; } }
    return;
#endif
    GEMM_BF16(ws + WS_A, ws + WS_WOUT, MTOK, DM, DM, ws + WS_F, DM, 1.f, 0);
    GSYNC();
#if defined(STOP_AFTER)
    if (STOP_AFTER == 7) return;
#endif
    ROW_PHASE(P.out, P.in[15], 1.0f, P.in[16], true);
    GSYNC();
#if defined(STOP_AFTER)
    if (STOP_AFTER == 8) return;
#endif
    GEMM_BF16(ws + WS_A, ws + WS_WQ, MTOK, DM, DM, ws + WS_F, DM, MEM_QSCALE, 0);
    GSYNC();
#if defined(STOP_AFTER)
    if (STOP_AFTER == 9) return;
#endif
    { PH_IDS const Params P = getp(); unsigned char* ws = P.ws;
#if !defined(SKIP_P10)
#ifndef P10_REPS
#define P10_REPS 1
#endif
      for (int rep10 = 0; rep10 < P10_REPS; ++rep10)
      for (int idx = bid; idx < 2048; idx += G) { const int qb = idx & 63, bhm = idx >> 6, b = bhm >> 2, h = bhm & 3;
          attn_unit<256, false>(lds, (const bf16_t*)(ws + WS_F) + (size_t)b * SEQ * 1024 + h * 256, 1024, (const bf16_t*)(ws + WS_KMEM) + (size_t)b * NMEM * 1024 + h * 256, 1024,
                                (const bf16_t*)(ws + WS_VMEMT) + (size_t)(h * 256) * (NB * NMEM) + (size_t)b * NMEM, NB * NMEM, (bf16_t*)(ws + WS_A) + (size_t)b * SEQ * 1024 + h * 256, 1024,
                                nullptr, qb, 0, 3, tid, wid, lane); }
#endif
    }
    GSYNC();
#if defined(STOP_AFTER)
    if (STOP_AFTER == 10) return;
#endif
    GEMM_BF16(ws + WS_A, ws + WS_WO, MTOK, DM, DM, ws + WS_F, DM, 1.f, 0);
    GSYNC();
#if defined(STOP_AFTER)
    if (STOP_AFTER == 11) return;
#endif
    ROW_PHASE(P.out, P.in[21], 1.0f, P.in[22], true);
    GSYNC();
#if defined(STOP_AFTER)
    if (STOP_AFTER == 12) return;
#endif
    GEMM_SWIGLU(ws + WS_WGU2);
    GSYNC();
#if defined(STOP_AFTER)
    if (STOP_AFTER == 13) return;
#endif
    GEMM_BF16(ws + WS_BIG, ws + WS_WD2, MTOK, DM, DFF, ws + WS_F, DM, 1.f, 0);
    GSYNC();
#if defined(STOP_AFTER)
    if (STOP_AFTER == 14) return;
#endif
    ROW_PHASE(P.out, P.in[26], 0.5f, (const float*)nullptr, false);
}

extern "C" void kernel_launch(void* const* d_in, const int* in_sizes, int n_in, void* d_out, int out_size, void* d_ws, size_t ws_size, hipStream_t stream) {
    static int grid = 0;
    if (grid == 0) {
        if (n_in != 27 || ws_size < WS_END) { fprintf(stderr, "kernel_launch: unexpected inputs (n_in %d, ws %zu)\n", n_in, ws_size); grid = -1; return; }
        int dev = 0, cus = 0, per_cu = 0;
        hipGetDevice(&dev); hipDeviceGetAttribute(&cus, hipDeviceAttributeMultiprocessorCount, dev);
        hipFuncSetAttribute((const void*)hymba_fwd, hipFuncAttributeMaxDynamicSharedMemorySize, LDS_BYTES);
        hipOccupancyMaxActiveBlocksPerMultiprocessor(&per_cu, (const void*)hymba_fwd, 512, LDS_BYTES);
        if (per_cu < 1) per_cu = 1;
        grid = cus * per_cu;
        fprintf(stderr, "kernel_launch: grid %d (%d CUs x %d)\n", grid, cus, per_cu);
    }
    if (grid < 0) return;
    Params p{};
    for (int i = 0; i < 27; ++i) p.in[i] = (const float*)d_in[i];
    p.out = (float*)d_out; p.ws = (unsigned char*)d_ws;
    void* args[] = {&p};
    hipError_t e = hipLaunchCooperativeKernel((const void*)hymba_fwd, dim3(grid), dim3(512), args, LDS_BYTES, stream);
    if (e != hipSuccess) fprintf(stderr, "kernel_launch: cooperative launch failed: %s (grid %d)\n", hipGetErrorString(e), grid);
}
```

```cpp
#include <hip/hip_runtime.h>
#include <hip/hip_cooperative_groups.h>
#include <cstdio>
#include <cstdint>
namespace cg = cooperative_groups;

namespace pg8 {
#define PG8_LAS __attribute__((address_space(3)))
typedef unsigned short bf16_t;
typedef short bf16x8 __attribute__((ext_vector_type(8)));
typedef float f32x4 __attribute__((ext_vector_type(4)));
typedef unsigned u32x4 __attribute__((ext_vector_type(4)));
constexpr int BM = 256, BK = 64, HALF = 128, HTB = HALF * BK * 2  , STAGE_BYTES = 8 * HTB, NXCD = 8, WGM = 8;

__host__ __device__ __forceinline__ int lds_byte(int r, int c) { const int st = (r >> 4) * 2 + (c >> 5), rr = r & 15, cc = c & 31, ob = rr * 64 + cc * 2; return st * 1024 + (ob ^ (((ob >> 9) & 1) << 5)); }
__host__ __device__ __forceinline__ void stage_rc(int b, int& R, int& C) { const int st = b / 1024, sb = b % 1024, swz = sb ^ (((sb >> 9) & 1) << 5); R = (st >> 1) * 16 + swz / 64; C = (st & 1) * 32 + (swz % 64) / 2; }
__host__ __device__ __forceinline__ int perm32(int rho) { const int n = rho >> 4, i = rho & 15; return 8 * (i >> 2) + 4 * n + (i & 3); }

struct Unit { int pm, pn; };
struct Gemm { const bf16_t* A; const bf16_t* Bt; int M, N, K; size_t bbs; int bsh; };

struct StaticOrder {
    int nM, nN, nwg, G, c;
    __host__ __device__ void init(int M, int N, int G_, int c_) { nM = M / BM; nN = N / BM; nwg = nM * nN; G = G_; c = c_; }
    __host__ __device__ bool next(int i, Unit& u) const {
        const long L = (long)i * G + c; if (L >= nwg) return false;
        int wgid = (int)L; { const int q = nwg / NXCD, r = nwg % NXCD, xcd = wgid % NXCD, off = wgid / NXCD; wgid = (xcd < r ? xcd * (q + 1) : r * (q + 1) + (xcd - r) * q) + off; }
        const int nig = WGM * nN, gid = wgid / nig, fm = gid * WGM, gsz = (nM - fm) < WGM ? (nM - fm) : WGM;
        u.pm = fm + ((wgid % nig) % gsz); u.pn = (wgid % nig) / gsz; return true;
    }
    __device__ __forceinline__ void a_ready(const Unit&) const {}
    __device__ __forceinline__ void done(const Unit&) const {}
};

typedef float f32x2_t __attribute__((ext_vector_type(2))); typedef __bf16 bf16x2_t __attribute__((ext_vector_type(2)));
__device__ __forceinline__ unsigned cvt_pk_bf16(float lo, float hi) { f32x2_t v = {lo, hi}; bf16x2_t b = __builtin_convertvector(v, bf16x2_t); return __builtin_bit_cast(unsigned, b); }
struct EpiBf16 {
    static constexpr bool PERM = true, AFTER_DRAIN = false;
    bf16_t* O; int ldc; float scale;
    __device__ __forceinline__ void operator()(const f32x4 (&acc)[2][2][4][2], const Unit& u, int wr, int wc, int fr, int fq) const {
        const int row0 = u.pm * BM + wr * 64 + fr; const int col0 = u.pn * BM + wc * 32 + 8 * fq; const float sc = scale;
#pragma unroll
        for (int ai = 0; ai < 2; ++ai)
#pragma unroll
            for (int m = 0; m < 4; ++m) { bf16_t* rowp = O + (size_t)(row0 + ai * HALF + m * 16) * ldc + col0;
#pragma unroll
                for (int bj = 0; bj < 2; ++bj) { f32x4 v0 = acc[ai][bj][m][0] * sc, v1 = acc[ai][bj][m][1] * sc;
                    u32x4 w; w.x = cvt_pk_bf16(v0[0], v0[1]); w.y = cvt_pk_bf16(v0[2], v0[3]); w.z = cvt_pk_bf16(v1[0], v1[1]); w.w = cvt_pk_bf16(v1[2], v1[3]);
                    *(u32x4*)(rowp + bj * HALF) = w; } asm volatile("" ::: "memory"); }
    }
};
__device__ __forceinline__ float silu_f(float x) { return x * __builtin_amdgcn_rcpf(1.0f + __builtin_amdgcn_exp2f(-1.4426950408889634f * x)); }
struct EpiSwiGLU {
    static constexpr bool PERM = true, AFTER_DRAIN = false;
    bf16_t* O; int ldc;
    __device__ __forceinline__ void operator()(const f32x4 (&acc)[2][2][4][2], const Unit& u, int wr, int wc, int fr, int fq) const {
        const int row0 = u.pm * BM + wr * 64 + fr; const int col0 = u.pn * HALF + wc * 32 + 8 * fq;
#pragma unroll
        for (int ai = 0; ai < 2; ++ai)
#pragma unroll
            for (int m = 0; m < 4; ++m) { bf16_t* rowp = O + (size_t)(row0 + ai * HALF + m * 16) * ldc + col0;
                const f32x4 g0 = acc[ai][0][m][0], g1 = acc[ai][0][m][1], u0 = acc[ai][1][m][0], u1 = acc[ai][1][m][1];
                float h[8];
#pragma unroll
                for (int e = 0; e < 4; ++e) { h[e] = silu_f(g0[e]) * u0[e]; h[4 + e] = silu_f(g1[e]) * u1[e]; }
                u32x4 w; w.x = cvt_pk_bf16(h[0], h[1]); w.y = cvt_pk_bf16(h[2], h[3]); w.z = cvt_pk_bf16(h[4], h[5]); w.w = cvt_pk_bf16(h[6], h[7]);
                *(u32x4*)rowp = w; asm volatile("" ::: "memory"); }
    }
};
struct EpiProj {
    static constexpr bool PERM = true, AFTER_DRAIN = false;
    bf16_t* PJ; float* SM; float qscale;
    __device__ __forceinline__ void operator()(const f32x4 (&acc)[2][2][4][2], const Unit& u, int wr, int wc, int fr, int fq) const {
        const int row0 = u.pm * BM + wr * 64 + fr;
        if (u.pn < 12) {
            const int col0 = u.pn * BM + wc * 32 + 8 * fq; const float sc = (u.pn < 2) ? qscale : 1.0f;
#pragma unroll
            for (int ai = 0; ai < 2; ++ai)
#pragma unroll
                for (int m = 0; m < 4; ++m) { bf16_t* rowp = PJ + (size_t)(row0 + ai * HALF + m * 16) * 3072 + col0;
#pragma unroll
                    for (int bj = 0; bj < 2; ++bj) { f32x4 v0 = acc[ai][bj][m][0] * sc, v1 = acc[ai][bj][m][1] * sc;
                        u32x4 w; w.x = cvt_pk_bf16(v0[0], v0[1]); w.y = cvt_pk_bf16(v0[2], v0[3]); w.z = cvt_pk_bf16(v1[0], v1[1]); w.w = cvt_pk_bf16(v1[2], v1[3]);
                        *(u32x4*)(rowp + bj * HALF) = w; } asm volatile("" ::: "memory"); }
        } else if (wc == 0 && fq < 2) {
#pragma unroll
            for (int ai = 0; ai < 2; ++ai)
#pragma unroll
                for (int m = 0; m < 4; ++m) { float* rowp = SM + (size_t)(row0 + ai * HALF + m * 16) * 16 + 8 * fq;
                    *(f32x4*)rowp = acc[ai][0][m][0]; *(f32x4*)(rowp + 4) = acc[ai][0][m][1]; }
        }
    }
};
template <int LDC> struct EpiBf16Map {
    static constexpr bool PERM = true, AFTER_DRAIN = false;
    bf16_t* O; int sh; size_t lo_off, hi_off, pn_off; float scale;
    __device__ __forceinline__ void operator()(const f32x4 (&acc)[2][2][4][2], const Unit& u, int wr, int wc, int fr, int fq) const {
        bf16_t* base = O + (size_t)(u.pm & ((1 << sh) - 1)) * lo_off + (size_t)(u.pm >> sh) * hi_off + (size_t)u.pn * pn_off + (size_t)(wr * 64 + fr) * LDC + (wc * 32 + 8 * fq); const float sc = scale;
#pragma unroll
        for (int ai = 0; ai < 2; ++ai)
#pragma unroll
            for (int m = 0; m < 4; ++m) { bf16_t* rowp = base + (ai * HALF + m * 16) * LDC;
#pragma unroll
                for (int bj = 0; bj < 2; ++bj) { f32x4 v0 = acc[ai][bj][m][0] * sc, v1 = acc[ai][bj][m][1] * sc;
                    u32x4 w; w.x = cvt_pk_bf16(v0[0], v0[1]); w.y = cvt_pk_bf16(v0[2], v0[3]); w.z = cvt_pk_bf16(v1[0], v1[1]); w.w = cvt_pk_bf16(v1[2], v1[3]);
                    *(u32x4*)(rowp + bj * HALF) = w; } asm volatile("" ::: "memory"); }
    }
};
struct EpiSoftmax {
    static constexpr bool PERM = true, AFTER_DRAIN = false;
    bf16_t* O; int ldc; PG8_LAS unsigned char* xl;
    __device__ __forceinline__ void operator()(const f32x4 (&acc_in)[2][2][4][2], const Unit& u, int wr, int wc, int fr, int fq) const {
        f32x4 (&acc)[2][2][4][2] = const_cast<f32x4 (&)[2][2][4][2]>(acc_in);
        PG8_LAS f32x4* PM = (PG8_LAS f32x4*)xl; PG8_LAS f32x4* PS = (PG8_LAS f32x4*)(xl + 4096);
        PG8_LAS float* PMf = (PG8_LAS float*)xl; PG8_LAS float* PSf = (PG8_LAS float*)(xl + 4096);
#pragma unroll
        for (int ai = 0; ai < 2; ++ai)
#pragma unroll
            for (int m = 0; m < 4; ++m) { float mx = -INFINITY;
#pragma unroll
                for (int bj = 0; bj < 2; ++bj)
#pragma unroll
                    for (int n = 0; n < 2; ++n) { const f32x4 x = acc[ai][bj][m][n]; mx = fmaxf(mx, fmaxf(fmaxf(x[0], x[1]), fmaxf(x[2], x[3]))); }
                mx = fmaxf(mx, __shfl_xor(mx, 16)); mx = fmaxf(mx, __shfl_xor(mx, 32));
                if (fq == 0) PMf[(ai * HALF + wr * 64 + m * 16 + fr) * 4 + wc] = mx; }
        asm volatile("s_waitcnt lgkmcnt(0)" ::: "memory"); __builtin_amdgcn_s_barrier(); asm volatile("" ::: "memory");
#pragma unroll
        for (int ai = 0; ai < 2; ++ai)
#pragma unroll
            for (int m = 0; m < 4; ++m) { const int r = ai * HALF + wr * 64 + m * 16 + fr; const f32x4 p = PM[r]; const float rm = fmaxf(fmaxf(p[0], p[1]), fmaxf(p[2], p[3])); float sm = 0.f;
#pragma unroll
                for (int bj = 0; bj < 2; ++bj)
#pragma unroll
                    for (int n = 0; n < 2; ++n) { const f32x4 x = acc[ai][bj][m][n];
                        const float e0 = __builtin_amdgcn_exp2f(x[0] - rm), e1 = __builtin_amdgcn_exp2f(x[1] - rm), e2 = __builtin_amdgcn_exp2f(x[2] - rm), e3 = __builtin_amdgcn_exp2f(x[3] - rm);
                        sm += (e0 + e1) + (e2 + e3); acc[ai][bj][m][n] = (f32x4){e0, e1, e2, e3}; }
                sm += __shfl_xor(sm, 16); sm += __shfl_xor(sm, 32);
                if (fq == 0) PSf[r * 4 + wc] = sm; }
        asm volatile("s_waitcnt lgkmcnt(0)" ::: "memory"); __builtin_amdgcn_s_barrier(); asm volatile("" ::: "memory");
        const int row0 = u.pm * BM + wr * 64 + fr; const int col0 = u.pn * BM + wc * 32 + 8 * fq;
#pragma unroll
        for (int ai = 0; ai < 2; ++ai)
#pragma unroll
            for (int m = 0; m < 4; ++m) { const int r = ai * HALF + wr * 64 + m * 16 + fr; const f32x4 p = PS[r]; const float inv = 1.0f / ((p[0] + p[1]) + (p[2] + p[3]));
                bf16_t* rowp = O + (size_t)(row0 + ai * HALF + m * 16) * ldc + col0;
#pragma unroll
                for (int bj = 0; bj < 2; ++bj) { const f32x4 v0 = acc[ai][bj][m][0] * inv, v1 = acc[ai][bj][m][1] * inv;
                    u32x4 w; w.x = cvt_pk_bf16(v0[0], v0[1]); w.y = cvt_pk_bf16(v0[2], v0[3]); w.z = cvt_pk_bf16(v1[0], v1[1]); w.w = cvt_pk_bf16(v1[2], v1[3]);
                    *(u32x4*)(rowp + bj * HALF) = w; } asm volatile("" ::: "memory"); }
    }
};
template <class Epi, class Sched, bool ALIGN_EPI = false, bool SP2 = false>
__device__ __forceinline__ void gemm_phase(PG8_LAS unsigned char* lds, const Gemm g, const Sched& S, const Epi& E) {
    int tid_l = threadIdx.x; asm volatile("" : "+v"(tid_l));
    const int tid = tid_l, wid = __builtin_amdgcn_readfirstlane(tid >> 6), lane = tid & 63, wr = wid >> 2, wc = wid & 3, fr = lane & 15, fq = lane >> 4;
    const int K = g.K, nt = K / BK;
    unsigned voffA[2], voffB[2];
#pragma unroll
    for (int i = 0; i < 2; ++i) { int R, C; stage_rc(tid * 16 + i * 8192, R, C); const int Rb = Epi::PERM ? ((R & ~31) + perm32(R & 31)) : R;
        voffA[i] = (unsigned)(R * K + C) * 2u; voffB[i] = (unsigned)(Rb * K + C) * 2u; }
    const size_t kstep = (size_t)(BK * 2);
    const size_t hstep = (size_t)HALF * K * 2;
    const size_t tstep = 2 * hstep;
    const unsigned ldsw = (unsigned)wid * 1024u;
    const int aoff = lds_byte(wr * 64 + fr, fq * 8), boff = lds_byte(wc * 32 + fr, fq * 8);
#define PG8_SA(b, h) (((b) * 2 + (h)) * HTB)
#define PG8_SB(b, h) ((4 + (b) * 2 + (h)) * HTB)
#define PG8_STAGE(bufoff, gbase, voff) do { _Pragma("unroll") for (int _i = 0; _i < 2; ++_i) \
        __builtin_amdgcn_global_load_lds((const unsigned*)((const char*)(gbase) + (voff)[_i]), (PG8_LAS unsigned*)(lds + (bufoff) + ldsw + _i * 8192), 16, 0, 0); } while (0)
#define PG8_LDA(dst, b, h) do { _Pragma("unroll") for (int m = 0; m < 4; ++m) _Pragma("unroll") for (int k = 0; k < 2; ++k) dst[m][k] = *(const PG8_LAS bf16x8*)(lds + PG8_SA(b, h) + aoff + m * 2048 + k * 1024); } while (0)
#define PG8_LDB(dst, b, h) do { _Pragma("unroll") for (int n = 0; n < 2; ++n) _Pragma("unroll") for (int k = 0; k < 2; ++k) dst[n][k] = *(const PG8_LAS bf16x8*)(lds + PG8_SB(b, h) + boff + n * 2048 + k * 1024); } while (0)
#define PG8_MMA(ai, bj, At, Bt) do { __builtin_amdgcn_s_setprio(1); _Pragma("unroll") for (int m = 0; m < 4; ++m) _Pragma("unroll") for (int n = 0; n < 2; ++n) _Pragma("unroll") for (int k = 0; k < 2; ++k) \
        acc[ai][bj][m][n] = __builtin_amdgcn_mfma_f32_16x16x32_bf16(Bt[n][k], At[m][k], acc[ai][bj][m][n], 0, 0, 0); __builtin_amdgcn_s_setprio(0); } while (0)
#define PG8_WAIT_V(n) asm volatile("s_waitcnt vmcnt(" #n ")" ::: "memory")
#define PG8_WAIT_L(n) asm volatile("s_waitcnt lgkmcnt(" #n ")" ::: "memory")
#define PG8_BAR __builtin_amdgcn_s_barrier()
#define PG8_SCHED __builtin_amdgcn_sched_barrier(0)
    Unit cur, nxt; int ui = 0;
    if (!S.next(0, cur)) return;
    f32x4 acc[2][2][4][2];
#pragma unroll
    for (int a = 0; a < 2; ++a)
#pragma unroll
        for (int b = 0; b < 2; ++b)
#pragma unroll
            for (int m = 0; m < 4; ++m)
#pragma unroll
                for (int n = 0; n < 2; ++n) acc[a][b][m][n] = (f32x4){0.f, 0.f, 0.f, 0.f};
    bf16x8 At[4][2], B0[2][2], B1[2][2];
    const char* cA = (const char*)g.A + (size_t)cur.pm * tstep; const char* cB = (const char*)g.Bt + (size_t)cur.pn * tstep + (size_t)(cur.pm >> g.bsh) * g.bbs;
    S.a_ready(cur);
    if constexpr (SP2) {
        PG8_STAGE(PG8_SB(0, 0), cB, voffB); PG8_STAGE(PG8_SB(0, 1), cB + hstep, voffB); PG8_STAGE(PG8_SA(0, 0), cA, voffA); PG8_STAGE(PG8_SA(0, 1), cA + hstep, voffA);
        if (wr == 1) PG8_BAR;
        PG8_WAIT_V(2); PG8_BAR;
        PG8_STAGE(PG8_SB(1, 0), cB + kstep, voffB); PG8_STAGE(PG8_SA(1, 0), cA + kstep, voffA); PG8_STAGE(PG8_SB(1, 1), cB + hstep + kstep, voffB);
        PG8_WAIT_V(6); PG8_BAR;
    } else {
        PG8_STAGE(PG8_SB(0, 0), cB, voffB); PG8_STAGE(PG8_SA(0, 0), cA, voffA); PG8_STAGE(PG8_SB(0, 1), cB + hstep, voffB); PG8_STAGE(PG8_SA(0, 1), cA + hstep, voffA);
        if (wr == 1) PG8_BAR;
        PG8_WAIT_V(4); PG8_BAR;
        PG8_STAGE(PG8_SB(1, 0), cB + kstep, voffB); PG8_STAGE(PG8_SA(1, 0), cA + kstep, voffA); PG8_STAGE(PG8_SB(1, 1), cB + hstep + kstep, voffB);
        PG8_WAIT_V(6); PG8_BAR;
    }
    for (;;) {
        const bool has_next = S.next(ui + 1, nxt);
        const char* nA = has_next ? (const char*)g.A + (size_t)nxt.pm * tstep : cA; const char* nB = has_next ? (const char*)g.Bt + (size_t)nxt.pn * tstep + (size_t)(nxt.pm >> g.bsh) * g.bbs : cB;
        for (int t = 0; t < nt; t += 2) {
            const bool last = (t == nt - 2);
            const char* a1 = cA + (size_t)(t + 1) * kstep;
            const char* a2 = last ? nA : cA + (size_t)(t + 2) * kstep; const char* b2 = last ? nB : cB + (size_t)(t + 2) * kstep;
            const char* a3 = a2 + kstep; const char* b3 = b2 + kstep;
            if (last && has_next) S.a_ready(nxt);
            if constexpr (SP2) {
            PG8_LDB(B0, 0, 0); PG8_LDB(B1, 0, 1); PG8_SCHED; PG8_LDA(At, 0, 0); PG8_STAGE(PG8_SA(1, 1), a1 + hstep, voffA);
            PG8_WAIT_V(8); PG8_WAIT_L(0); PG8_BAR; PG8_MMA(0, 0, At, B0); PG8_MMA(0, 1, At, B1); PG8_BAR; PG8_SCHED;
            PG8_LDA(At, 0, 1); PG8_STAGE(PG8_SB(0, 0), b2, voffB); PG8_STAGE(PG8_SB(0, 1), b2 + hstep, voffB); PG8_STAGE(PG8_SA(0, 0), a2, voffA);
            PG8_WAIT_V(8); PG8_WAIT_L(0); PG8_BAR; PG8_MMA(1, 0, At, B0); PG8_MMA(1, 1, At, B1); PG8_BAR; PG8_SCHED;
            PG8_LDB(B0, 1, 0); PG8_LDB(B1, 1, 1); PG8_SCHED; PG8_LDA(At, 1, 0); PG8_STAGE(PG8_SA(0, 1), a2 + hstep, voffA);
            PG8_WAIT_V(8); PG8_WAIT_L(0); PG8_BAR; PG8_MMA(0, 0, At, B0); PG8_MMA(0, 1, At, B1); PG8_BAR; PG8_SCHED;
            PG8_LDA(At, 1, 1); PG8_STAGE(PG8_SB(1, 0), b3, voffB); PG8_STAGE(PG8_SB(1, 1), b3 + hstep, voffB); PG8_STAGE(PG8_SA(1, 0), a3, voffA);
            PG8_WAIT_V(8); PG8_WAIT_L(0); PG8_BAR; PG8_MMA(1, 0, At, B0); PG8_MMA(1, 1, At, B1); PG8_BAR; PG8_SCHED;
            } else {
            PG8_LDB(B0, 0, 0); PG8_SCHED; PG8_LDA(At, 0, 0); PG8_STAGE(PG8_SA(1, 1), a1 + hstep, voffA);
            PG8_WAIT_L(8); PG8_BAR; PG8_WAIT_L(0); PG8_MMA(0, 0, At, B0); PG8_BAR; PG8_SCHED;
            PG8_LDB(B1, 0, 1); PG8_STAGE(PG8_SB(0, 0), b2, voffB);
            PG8_BAR; PG8_WAIT_L(0); PG8_MMA(0, 1, At, B1); PG8_BAR;
            PG8_LDA(At, 0, 1); PG8_STAGE(PG8_SA(0, 0), a2, voffA);
            PG8_BAR; PG8_WAIT_L(0); PG8_MMA(1, 0, At, B0); PG8_BAR; PG8_SCHED;
            PG8_STAGE(PG8_SB(0, 1), b2 + hstep, voffB);
            PG8_WAIT_V(6); PG8_BAR; PG8_MMA(1, 1, At, B1); PG8_BAR;
            PG8_LDB(B0, 1, 0); PG8_SCHED; PG8_LDA(At, 1, 0); PG8_STAGE(PG8_SA(0, 1), a2 + hstep, voffA);
            PG8_WAIT_L(8); PG8_BAR; PG8_WAIT_L(0); PG8_MMA(0, 0, At, B0); PG8_BAR; PG8_SCHED;
            PG8_LDB(B1, 1, 1); PG8_STAGE(PG8_SB(1, 0), b3, voffB);
            PG8_BAR; PG8_WAIT_L(0); PG8_MMA(0, 1, At, B1); PG8_BAR;
            PG8_LDA(At, 1, 1); PG8_STAGE(PG8_SA(1, 0), a3, voffA);
            PG8_BAR; PG8_WAIT_L(0); PG8_MMA(1, 0, At, B0); PG8_BAR; PG8_SCHED;
            PG8_STAGE(PG8_SB(1, 1), b3 + hstep, voffB);
            PG8_WAIT_V(6); PG8_BAR; PG8_MMA(1, 1, At, B1); PG8_BAR;
            }
        }
        if constexpr (ALIGN_EPI) { if (wr == 0) PG8_BAR; }
        if constexpr (!Epi::AFTER_DRAIN) { E(acc, cur, wr, wc, fr, fq); S.done(cur); }
        if (!has_next) break;
#pragma unroll
        for (int a = 0; a < 2; ++a)
#pragma unroll
            for (int b = 0; b < 2; ++b)
#pragma unroll
                for (int m = 0; m < 4; ++m)
#pragma unroll
                    for (int n = 0; n < 2; ++n) acc[a][b][m][n] = (f32x4){0.f, 0.f, 0.f, 0.f};
        cur = nxt; cA = nA; cB = nB; ++ui;
        if constexpr (ALIGN_EPI) { if (wr == 1) PG8_BAR; }
    }
    PG8_WAIT_V(0);
    if constexpr (!ALIGN_EPI) { if (wr == 0) PG8_BAR; }
    PG8_BAR;
    if constexpr (Epi::AFTER_DRAIN) { E.fused(acc, cur, wr, wc, fr, fq, lds, wid, lane); S.done(cur); }
#undef PG8_SA
#undef PG8_SB
#undef PG8_STAGE
#undef PG8_LDA
#undef PG8_LDB
#undef PG8_MMA
#undef PG8_WAIT_V
#undef PG8_WAIT_L
#undef PG8_BAR
#undef PG8_SCHED
}
}
#define LAS __attribute__((address_space(3)))
typedef unsigned short bf16_t;
typedef short bf16x8 __attribute__((ext_vector_type(8)));
typedef float f32x4 __attribute__((ext_vector_type(4)));
typedef unsigned u32x4 __attribute__((ext_vector_type(4)));
typedef unsigned u32x2 __attribute__((ext_vector_type(2)));
using pg8::cvt_pk_bf16;
constexpr int SEQ = 8192, NB = 8, MTOK = NB * SEQ, DM = 1024, DFF = 2816, NMEM = 256;
constexpr float EPSN = 1e-6f, LOG2E = 1.4426950408889634f;
constexpr float FOX_QSCALE = 0.125f * LOG2E;
constexpr float MEM_QSCALE = 0.0625f * LOG2E;
constexpr float FOX_T2 = 40.0f;
constexpr size_t MiB = 1u << 20;
constexpr size_t WS_CTL = 0, CTL_BYTES = 32768, WS_XBAR = 65536;
constexpr size_t WS_SM = 2 * MiB, WS_FC = 6 * MiB, WS_KMEM = 8 * MiB, WS_VMEMT = 12 * MiB, WS_AMEM = 16 * MiB, WS_MISC = 20 * MiB;
constexpr size_t WS_WGU1 = 24 * MiB, WS_WD1 = 35 * MiB, WS_WIN = 41 * MiB, WS_WVT = 48 * MiB, WS_WOUT = 49 * MiB, WS_WQ = 51 * MiB, WS_WKV = 53 * MiB, WS_WO = 57 * MiB, WS_WGU2 = 59 * MiB, WS_WD2 = 70 * MiB;
constexpr size_t WS_A = 80 * MiB, WS_F = 208 * MiB, WS_BIG = 336 * MiB, WS_VT = 720 * MiB, WS_UT = 784 * MiB, WS_KTT = 848 * MiB, WS_ATT = 912 * MiB, WS_END = 1008 * MiB;
constexpr size_t WS_NW = WS_F, WS_QD = WS_F + 64 * MiB;
constexpr size_t WS_ORAW = 944 * MiB;
constexpr size_t WS_WQH = 76 * MiB, WS_WOTH = 78 * MiB;
constexpr size_t WS_MB = 848 * MiB, WS_NB = 864 * MiB;
constexpr size_t WS_HB = WS_VT;
constexpr size_t WS_XS = 944 * MiB, XS_BYTES = (size_t)65536 * 16 * 4, WS_XCNT = 262144;
constexpr size_t MISC_KT0 = 0, MISC_EGL = 65536;
constexpr int LDS_BYTES = 153600;
constexpr int LDS_BCAST = 152000;

struct Params { const float* in[27]; float* out; unsigned char* ws; };

__device__ __forceinline__ float bf2f(unsigned short b) { return __uint_as_float((unsigned)b << 16); }
__device__ __forceinline__ float bflo(unsigned w) { return __uint_as_float(w << 16); }
__device__ __forceinline__ float bfhi(unsigned w) { return __uint_as_float(w & 0xffff0000u); }
__device__ __forceinline__ float wave_sum(float v) {
#pragma unroll
    for (int o = 1; o < 64; o <<= 1) v += __shfl_xor(v, o);
    return v;
}
__device__ __forceinline__ float softplus_f(float x) { return fmaxf(x, 0.f) + log1pf(__expf(-fabsf(x))); }
#define LDS_WAIT() asm volatile("s_waitcnt lgkmcnt(0)" ::: "memory")

#define XB_TMO      128
#define XB_XCNT(j)  (256  + 64 * (j))
#define XB_XSUB(j)  (1280 + 64 * (j))
#define XB_XGEN(j)  (2304 + 64 * (j))
#define XB_TOP      3328
#define XB_TOPGEN   3392
#define XCD_BAR_WORDS 3456
#define XB_SPIN_CAP (1u << 18)

__device__ __forceinline__ unsigned xb_ld(unsigned* p)              { return __hip_atomic_load(p, __ATOMIC_RELAXED, __HIP_MEMORY_SCOPE_AGENT); }
__device__ __forceinline__ unsigned xb_add(unsigned* p, unsigned v) { return __hip_atomic_fetch_add(p, v, __ATOMIC_RELAXED, __HIP_MEMORY_SCOPE_AGENT); }
__device__ __forceinline__ unsigned xb_xcc_id() { return (unsigned)__builtin_amdgcn_s_getreg((3 << 11) | 20) & 0xFu; }
#define XB_SPIN(cond, bar) do { unsigned _sp = 0; while (cond) { __builtin_amdgcn_s_sleep(1); \
    if ((++_sp & 255u) == 0u) { if (xb_ld(&(bar)[XB_TMO])) break; if (_sp > XB_SPIN_CAP) { atomicAdd(&(bar)[XB_TMO], 1u); break; } } } } while (0)

struct XcdBarrier {
    unsigned* bar; unsigned x;
    volatile LAS unsigned* st;
};

__device__ __forceinline__ XcdBarrier xcd_barrier_post(unsigned* bar, volatile LAS unsigned* st) {
    XcdBarrier b; b.bar = bar; b.x = xb_xcc_id(); b.st = st;
    if (threadIdx.x == 0) (void)xb_add(&bar[XB_XCNT(b.x)], 1u);
    return b;
}
__device__ __forceinline__ void xcd_barrier_complete(unsigned* bar, unsigned x, unsigned& nloc, unsigned& nx) {
    const unsigned G = gridDim.x * gridDim.y * gridDim.z;
    unsigned sum, cnt, mine, sp = 0u;
    for (;;) {
        sum = 0u; cnt = 0u; mine = 0u;
#pragma unroll
        for (unsigned j = 0; j < 16; ++j) { const unsigned c = xb_ld(&bar[XB_XCNT(j)]); sum += c; cnt += (c > 0u) ? 1u : 0u; mine = (j == x) ? c : mine; }
        if (sum == G) break;
        __builtin_amdgcn_s_sleep(1);
        if ((++sp & 255u) == 0u) { if (xb_ld(&bar[XB_TMO])) break; if (sp > XB_SPIN_CAP) { atomicAdd(&bar[XB_TMO], 1u); break; } }
    }
    nloc = mine > 0u ? mine : 1u; nx = cnt > 0u ? cnt : 1u;
}

__device__ __forceinline__ void xcd_barrier(const XcdBarrier& b) {
    asm volatile("s_waitcnt vmcnt(0)" ::: "memory");
    __syncthreads();
    if (threadIdx.x == 0) {
        unsigned* bar = b.bar;
        __builtin_amdgcn_s_waitcnt(0);
        unsigned nloc = b.st[0], nx = b.st[1];
        if (nloc == 0u) { xcd_barrier_complete(bar, b.x, nloc, nx); b.st[0] = nloc; b.st[1] = nx; }
        const unsigned old = xb_add(&bar[XB_XSUB(b.x)], 1u);
        const unsigned gen = old / nloc;
        if (old + 1u == (gen + 1u) * nloc) {
            __builtin_amdgcn_fence(__ATOMIC_RELEASE, "agent");
            asm volatile("s_waitcnt vmcnt(0)" ::: "memory");
            const unsigned og = xb_add(&bar[XB_TOP], 1u);
            const unsigned tg = og / nx;
            if (og + 1u == (tg + 1u) * nx) xb_add(&bar[XB_TOPGEN], 1u);
            else XB_SPIN(xb_ld(&bar[XB_TOPGEN]) == tg, bar);
            __builtin_amdgcn_fence(__ATOMIC_ACQUIRE, "agent");
            xb_add(&bar[XB_XGEN(b.x)], 1u);
            asm volatile("s_waitcnt vmcnt(0)" ::: "memory");
        } else {
            XB_SPIN(xb_ld(&bar[XB_XGEN(b.x)]) == gen, bar);
            __builtin_amdgcn_fence(__ATOMIC_ACQUIRE, "agent");
            asm volatile("s_waitcnt vmcnt(0)" ::: "memory");
        }
    }
    __syncthreads();
}


struct MapIdent { int off; __device__ __forceinline__ int operator()(int n) const { return n + off; } };
struct MapGate { __device__ __forceinline__ int operator()(int n) const { return (n >> 7) * 256 + (n & 127); } };
struct MapUp { __device__ __forceinline__ int operator()(int n) const { return (n >> 7) * 256 + 128 + (n & 127); } };
struct MapWin { __device__ __forceinline__ int operator()(int n) const {
    if (n < 1024) return n; if (n < 1536) return -1; if (n < 1544) return 3072 + (n - 1536); if (n < 3592) return 1024 + (n - 1544); return 3080 + (n - 3592); } };
struct MapWinV { __device__ __forceinline__ int operator()(int n) const { return (n >= 1024 && n < 1536) ? n - 1024 : -1; } };

template <class Map> __device__ __forceinline__ void transpose_item(const float* W, int K, int N, bf16_t* WT, const Map map, LAS float* scr, int item, int lane) {
    const int nblk = (N + 31) >> 5, kb = item / nblk, nb = item - kb * nblk, k0 = 64 * kb, n0 = 32 * nb;
    const int r8 = lane >> 3, c4 = (lane & 7) * 4, nn = n0 + c4;
    f32x4 tv[8];
#pragma unroll
    for (int i = 0; i < 8; ++i) tv[i] = (nn < N) ? *(const f32x4*)(W + (size_t)(k0 + 8 * i + r8) * N + nn) : (f32x4){0.f, 0.f, 0.f, 0.f};
#pragma unroll
    for (int i = 0; i < 8; ++i) { LAS float* d = scr + (8 * i + r8) * 33 + c4; d[0] = tv[i].x; d[1] = tv[i].y; d[2] = tv[i].z; d[3] = tv[i].w; }
    LDS_WAIT(); asm volatile("" ::: "memory");
    const int c = lane & 7;
#pragma unroll
    for (int j = 0; j < 4; ++j) { const int nl = (lane >> 3) + 8 * j; const int n = n0 + nl; const LAS float* s = scr + (8 * c) * 33 + nl;
        if (n < N) { const int dr = map(n);
            if (dr >= 0) { u32x4 o; o.x = cvt_pk_bf16(s[0 * 33], s[1 * 33]); o.y = cvt_pk_bf16(s[2 * 33], s[3 * 33]); o.z = cvt_pk_bf16(s[4 * 33], s[5 * 33]); o.w = cvt_pk_bf16(s[6 * 33], s[7 * 33]);
                *(u32x4*)(WT + (size_t)dr * K + k0 + 8 * c) = o; } } }
    LDS_WAIT(); asm volatile("" ::: "memory");
}
template <class Map> __device__ __forceinline__ void transpose_all(const float* W, int K, int N, bf16_t* WT, const Map map, LAS float* scr, int gw, int ngw, int lane) {
    const int nitems = (K / 64) * ((N + 31) >> 5);
    for (int it = gw; it < nitems; it += ngw) transpose_item(W, K, N, WT, map, scr, it, lane);
}

__device__ __forceinline__ void row_phase(const float* hin, const bf16_t* hin_b, const bf16_t* Fb, const float* gpost, float wres, float* hout, bf16_t* hout_b, const float* gnext, bf16_t* Aout, int nrows, int gw, int ngw, int lane) {
    f32x4 gp[4], gn[4];
#pragma unroll
    for (int j = 0; j < 4; ++j) { gp[j] = Fb ? ((const f32x4*)gpost)[lane + 64 * j] : (f32x4){0.f, 0.f, 0.f, 0.f}; gn[j] = Aout ? ((const f32x4*)gnext)[lane + 64 * j] : (f32x4){0.f, 0.f, 0.f, 0.f}; }
    constexpr int RQ = 4;
    for (int r0 = gw; r0 < nrows; r0 += RQ * ngw) {
        f32x4 v[RQ][4]; u32x2 fw[RQ][4];
#pragma unroll
        for (int q = 0; q < RQ; ++q) { const int r = r0 + q * ngw;
            if (r < nrows) {
#pragma unroll
                for (int j = 0; j < 4; ++j) {
                    if (hin_b) { const u32x2 w = ((const u32x2*)(hin_b + (size_t)r * DM))[lane + 64 * j]; v[q][j] = (f32x4){bflo(w.x), bfhi(w.x), bflo(w.y), bfhi(w.y)}; }
                    else v[q][j] = ((const f32x4*)(hin + (size_t)r * DM))[lane + 64 * j];
                    if (Fb) fw[q][j] = ((const u32x2*)(Fb + (size_t)r * DM))[lane + 64 * j]; } } }
#pragma unroll
        for (int q = 0; q < RQ; ++q) { const int r = r0 + q * ngw;
            if (r < nrows) {
                if (Fb) {
                    f32x4 f[4]; float ss = 0.f;
#pragma unroll
                    for (int j = 0; j < 4; ++j) { const u32x2 w = fw[q][j];
                        f[j] = (f32x4){bflo(w.x), bfhi(w.x), bflo(w.y), bfhi(w.y)}; ss += (f[j].x * f[j].x + f[j].y * f[j].y) + (f[j].z * f[j].z + f[j].w * f[j].w); }
                    const float rs = wres * rsqrtf(wave_sum(ss) * (1.f / DM) + EPSN);
#pragma unroll
                    for (int j = 0; j < 4; ++j) v[q][j] = v[q][j] + (f[j] * rs) * gp[j];
                }
                if (hout) {
#pragma unroll
                    for (int j = 0; j < 4; ++j) ((f32x4*)(hout + (size_t)r * DM))[lane + 64 * j] = v[q][j];
                }
                if (hout_b) {
#pragma unroll
                    for (int j = 0; j < 4; ++j) { u32x2 w; w.x = cvt_pk_bf16(v[q][j].x, v[q][j].y); w.y = cvt_pk_bf16(v[q][j].z, v[q][j].w); ((u32x2*)(hout_b + (size_t)r * DM))[lane + 64 * j] = w; }
                }
                if (Aout) {
                    float ss = 0.f;
#pragma unroll
                    for (int j = 0; j < 4; ++j) ss += (v[q][j].x * v[q][j].x + v[q][j].y * v[q][j].y) + (v[q][j].z * v[q][j].z + v[q][j].w * v[q][j].w);
                    const float rs = rsqrtf(wave_sum(ss) * (1.f / DM) + EPSN);
#pragma unroll
                    for (int j = 0; j < 4; ++j) { const f32x4 o = (v[q][j] * rs) * gn[j]; u32x2 w; w.x = cvt_pk_bf16(o.x, o.y); w.y = cvt_pk_bf16(o.z, o.w);
                        ((u32x2*)(Aout + (size_t)r * DM))[lane + 64 * j] = w; }
                }
            } }
    }
}

template <int D, bool FOX, int QG>
__device__ __forceinline__ void attn_unit(LAS unsigned char* lds, const bf16_t* Q, int ldq, const bf16_t* K, int ldk, const bf16_t* VT, int ldvt, bf16_t* O, int ldo,
                                          const float* Fc, int qb, int kt0, int kt1, int tid, int wid, int lane) {
    constexpr int KP = D + 8, VP = 72, NP = D / 64, KS = D / 32, DJ = D / 16;
    LAS bf16_t* Kl = (LAS bf16_t*)lds; LAS bf16_t* Vl = (LAS bf16_t*)(lds + 64 * KP * 2); LAS float* Fk = (LAS float*)(lds + 64 * KP * 2 + D * VP * 2);
    const int fr = lane & 15, fq = lane >> 4;
    const int q0 = qb * (128 * QG) + wid * (16 * QG);
    bf16x8 qf[QG][KS]; float Fq[QG]; f32x4 o[QG][DJ]; float mrun[QG], lrun[QG];
#pragma unroll
    for (int g = 0; g < QG; ++g) {
#pragma unroll
        for (int ks = 0; ks < KS; ++ks) qf[g][ks] = *(const bf16x8*)(Q + (size_t)(q0 + 16 * g + fr) * ldq + 32 * ks + 8 * fq);
        Fq[g] = 0.f; if (FOX) Fq[g] = Fc[q0 + 16 * g + fr];
#pragma unroll
        for (int dj = 0; dj < DJ; ++dj) o[g][dj] = (f32x4){0.f, 0.f, 0.f, 0.f};
        mrun[g] = -INFINITY; lrun[g] = 0.f; }
    u32x4 kreg[NP], vreg[NP]; float fkreg = 0.f;
#define ATT_GLOAD(kt) do { _Pragma("unroll") for (int i_ = 0; i_ < NP; ++i_) { const int p_ = tid + 512 * i_; \
        { const int row_ = p_ / (D / 8), c_ = p_ % (D / 8); kreg[i_] = *(const u32x4*)(K + (size_t)((kt) * 64 + row_) * ldk + c_ * 8); } \
        { const int row_ = p_ >> 3, c_ = p_ & 7; vreg[i_] = *(const u32x4*)(VT + (size_t)row_ * ldvt + (kt) * 64 + c_ * 8); } } \
        if (FOX && tid < 64) fkreg = Fc[(kt) * 64 + tid]; } while (0)
    ATT_GLOAD(kt0);
    for (int kt = kt0; kt <= kt1; ++kt) {
        __syncthreads();
#pragma unroll
        for (int i = 0; i < NP; ++i) { const int p = tid + 512 * i;
            { const int row = p / (D / 8), c = p % (D / 8); *(LAS u32x4*)(Kl + row * KP + c * 8) = kreg[i]; }
            { const int row = p >> 3, c = p & 7; *(LAS u32x4*)(Vl + row * VP + c * 8) = vreg[i]; } }
        if (FOX && tid < 64) Fk[tid] = fkreg;
        __syncthreads();
        if (kt < kt1) ATT_GLOAD(kt + 1);
        if (FOX && kt * 64 > q0 + 16 * QG - 1) continue;
        f32x4 s[QG][4];
#pragma unroll
        for (int g = 0; g < QG; ++g)
#pragma unroll
            for (int j = 0; j < 4; ++j) { if (FOX) { const f32x4 fk4 = *(const LAS f32x4*)(Fk + 16 * j + 4 * fq); s[g][j] = Fq[g] - fk4; } else s[g][j] = (f32x4){0.f, 0.f, 0.f, 0.f}; }
#pragma unroll
        for (int ks = 0; ks < KS; ++ks)
#pragma unroll
            for (int j = 0; j < 4; ++j) { const bf16x8 kf = *(const LAS bf16x8*)(Kl + (16 * j + fr) * KP + 32 * ks + 8 * fq);
#pragma unroll
                for (int g = 0; g < QG; ++g) s[g][j] = __builtin_amdgcn_mfma_f32_16x16x32_bf16(kf, qf[g][ks], s[g][j], 0, 0, 0); }
        bf16x8 pf[QG][2];
#pragma unroll
        for (int g = 0; g < QG; ++g) {
            const int q0g = q0 + 16 * g;
            if (FOX && kt * 64 + 63 > q0g) {
#pragma unroll
                for (int j = 0; j < 4; ++j)
#pragma unroll
                    for (int r = 0; r < 4; ++r) { const int key = kt * 64 + 16 * j + 4 * fq + r; if (key > q0g + fr) s[g][j][r] = -INFINITY; }
            }
            float mx = fmaxf(fmaxf(s[g][0][0], s[g][0][1]), fmaxf(s[g][0][2], s[g][0][3]));
#pragma unroll
            for (int j = 1; j < 4; ++j) mx = fmaxf(mx, fmaxf(fmaxf(s[g][j][0], s[g][j][1]), fmaxf(s[g][j][2], s[g][j][3])));
            mx = fmaxf(mx, __shfl_xor(mx, 16)); mx = fmaxf(mx, __shfl_xor(mx, 32));
            const float mnew = fmaxf(mrun[g], mx);
            const float alpha = __builtin_amdgcn_exp2f(mrun[g] - mnew);
            mrun[g] = mnew;
            float ls = 0.f;
#pragma unroll
            for (int j = 0; j < 4; ++j)
#pragma unroll
                for (int r = 0; r < 4; ++r) { s[g][j][r] = __builtin_amdgcn_exp2f(s[g][j][r] - mnew); ls += s[g][j][r]; }
            lrun[g] = lrun[g] * alpha + ls;
#pragma unroll
            for (int dj = 0; dj < DJ; ++dj) o[g][dj] = o[g][dj] * alpha;
#pragma unroll
            for (int k2 = 0; k2 < 2; ++k2) { u32x4 w; w.x = cvt_pk_bf16(s[g][2 * k2][0], s[g][2 * k2][1]); w.y = cvt_pk_bf16(s[g][2 * k2][2], s[g][2 * k2][3]);
                w.z = cvt_pk_bf16(s[g][2 * k2 + 1][0], s[g][2 * k2 + 1][1]); w.w = cvt_pk_bf16(s[g][2 * k2 + 1][2], s[g][2 * k2 + 1][3]); pf[g][k2] = __builtin_bit_cast(bf16x8, w); }
        }
#pragma unroll
        for (int dj = 0; dj < DJ; ++dj)
#pragma unroll
            for (int k2 = 0; k2 < 2; ++k2) { const u32x2 lo = *(const LAS u32x2*)(Vl + (16 * dj + fr) * VP + 32 * k2 + 4 * fq), hi = *(const LAS u32x2*)(Vl + (16 * dj + fr) * VP + 32 * k2 + 16 + 4 * fq);
                const u32x4 w = (u32x4){lo.x, lo.y, hi.x, hi.y};
#pragma unroll
                for (int g = 0; g < QG; ++g) o[g][dj] = __builtin_amdgcn_mfma_f32_16x16x32_bf16(__builtin_bit_cast(bf16x8, w), pf[g][k2], o[g][dj], 0, 0, 0); }
    }
#undef ATT_GLOAD
#pragma unroll
    for (int g = 0; g < QG; ++g) {
        float l = lrun[g]; l += __shfl_xor(l, 16); l += __shfl_xor(l, 32);
        const float inv = 1.0f / l;
#pragma unroll
        for (int dj = 0; dj < DJ; ++dj) { u32x2 w; w.x = cvt_pk_bf16(o[g][dj][0] * inv, o[g][dj][1] * inv); w.y = cvt_pk_bf16(o[g][dj][2] * inv, o[g][dj][3] * inv);
            *(u32x2*)(O + (size_t)(q0 + 16 * g + fr) * ldo + 16 * dj + 4 * fq) = w; } }
    __syncthreads();
}

__device__ __forceinline__ void fox_prep(LAS unsigned char* lds, const Params& P, int bh, int tid, int wid, int lane) {
    LAS float* WS = (LAS float*)lds;
    LAS float* E = WS + 16;
    LAS float* F0 = E + 128;
    LAS unsigned* MX = (LAS unsigned*)(F0 + 64);
    const int b = bh >> 3, h = bh & 7;
    const float* SM = (const float*)(P.ws + WS_SM); float* FC = (float*)(P.ws + WS_FC) + (size_t)bh * SEQ;
    const bf16_t* PJ = (const bf16_t*)(P.ws + WS_BIG);
    const float bias = P.in[9][h];
    if (tid < 2) MX[tid] = 0u;
    float pre[16]; float run = 0.f;
#pragma unroll
    for (int i = 0; i < 16; ++i) { const float x = SM[(size_t)(b * SEQ + 16 * tid + i) * 16 + h] + bias; const float ls = -softplus_f(-x) * LOG2E; run += ls; pre[i] = run; }
    float sc = run;
#pragma unroll
    for (int off = 1; off < 64; off <<= 1) { const float v = __shfl_up(sc, off); if (lane >= off) sc += v; }
    if (lane == 63) WS[wid] = sc;
    __syncthreads();
    float base = sc - run;
    for (int w = 0; w < wid; ++w) base += WS[w];
#pragma unroll
    for (int i = 0; i < 16; ++i) { pre[i] += base; FC[16 * tid + i] = pre[i]; }
    if ((tid & 3) == 3) E[tid >> 2] = pre[15];
    if ((tid & 7) == 0) F0[tid >> 3] = pre[0];
    float mq = 0.f, mk = 0.f;
    for (int i = 0; i < 16; ++i) { const bf16_t* qrow = PJ + (size_t)(b * SEQ + 16 * tid + i) * 3072 + h * 64; float sq = 0.f, sk = 0.f;
#pragma unroll
        for (int c = 0; c < 8; ++c) { const u32x4 a = *(const u32x4*)(qrow + 8 * c), k4 = *(const u32x4*)(qrow + 512 + 8 * c);
#pragma unroll
            for (int e = 0; e < 4; ++e) { const float a0 = bflo(a[e]), a1 = bfhi(a[e]), k0 = bflo(k4[e]), k1 = bfhi(k4[e]); sq += a0 * a0 + a1 * a1; sk += k0 * k0 + k1 * k1; } }
        mq = fmaxf(mq, sq); mk = fmaxf(mk, sk); }
    atomicMax((unsigned*)MX, __float_as_uint(mq)); atomicMax((unsigned*)MX + 1, __float_as_uint(mk));
    __syncthreads();
    if (tid < 64) { const float bound = 2.0f * sqrtf(__uint_as_float(MX[0]) * __uint_as_float(MX[1])) * 1.01f + 1.0f;
        const float f0 = F0[tid]; int kt = 0; while (kt < 2 * tid && f0 - E[kt] + bound < -FOX_T2) ++kt;
        ((int*)(P.ws + WS_MISC + MISC_KT0))[bh * 64 + tid] = kt; }
    __syncthreads();
}

constexpr int GP_KL = 0, GP_QL = 17408, GP_RHS = 34816, RHSP = 260, GP_LL = GP_RHS + 64 * RHSP * 4, GP_GC = GP_LL + 16384, GP_BETA = GP_GC + 256, GP_CW = GP_BETA + 256;
__device__ __forceinline__ void gdn_prep_chunk(LAS unsigned char* lds, const Params& P, int ci, int tid, int wid, int lane) {
    LAS bf16_t* Kl = (LAS bf16_t*)(lds + GP_KL); LAS bf16_t* Ql = (LAS bf16_t*)(lds + GP_QL); LAS float* RHS = (LAS float*)(lds + GP_RHS); LAS float* Ll = (LAS float*)(lds + GP_LL);
    LAS float* GC = (LAS float*)(lds + GP_GC); LAS float* BETA = (LAS float*)(lds + GP_BETA); LAS float* CW = (LAS float*)(lds + GP_CW);
    const float* SM = (const float*)(P.ws + WS_SM); const bf16_t* PJ = (const bf16_t*)(P.ws + WS_BIG);
    const int t = tid >> 3, cg8 = tid & 7, ch0 = 16 * cg8;
    float ga_n = 0.f, gb_n = 0.f;
    if (wid == 0) { const size_t R_ = (size_t)(ci >> 9) * SEQ + (size_t)(ci & 127) * 64 + lane; ga_n = SM[R_ * 16 + 12 + ((ci >> 7) & 3)]; gb_n = SM[R_ * 16 + 8 + ((ci >> 7) & 3)]; }
    {
    const int h = (ci >> 7) & 3, c = ci & 127;
    bf16_t* NW = (bf16_t*)(P.ws + WS_NW) + (size_t)ci * 8192; bf16_t* QD = (bf16_t*)(P.ws + WS_QD) + (size_t)ci * 8192; bf16_t* ATT = (bf16_t*)(P.ws + WS_ATT) + (size_t)ci * 4096;
    bf16_t* KTT = (bf16_t*)(P.ws + WS_KTT) + (size_t)ci * 8192; bf16_t* UT = (bf16_t*)(P.ws + WS_UT) + (size_t)ci * 8192;
    if (wid == 0) {
        float g = -__expf(P.in[11][h]) * softplus_f(ga_n + P.in[12][h]);
#pragma unroll
        for (int off = 1; off < 64; off <<= 1) { const float v = __shfl_up(g, off); if (lane >= off) g += v; }
        GC[lane] = g; BETA[lane] = 1.0f / (1.0f + __expf(-gb_n));
        if (lane == 63) ((float*)(P.ws + WS_MISC + MISC_EGL))[ci] = __expf(g);
    }
    __syncthreads();
    {
        float y[3][16];
#pragma unroll
        for (int mat = 0; mat < 3; ++mat) {
#pragma unroll
            for (int e = 0; e < 16; ++e) y[mat][e] = 0.f;
            const bf16_t* src0 = PJ + ((size_t)(ci >> 9) * SEQ + c * 64 + t) * 3072 + 1024 + 512 * mat + h * 128 + ch0;
            const LAS float* wsrc0 = CW + 512 * mat + h * 128 + ch0;
            if (c * 64 + t >= 3) {
                u32x4 xr[4][2];
#pragma unroll
                for (int i = 0; i < 4; ++i) { xr[i][0] = *(const u32x4*)(src0 + (i - 3) * 3072); xr[i][1] = *(const u32x4*)(src0 + (i - 3) * 3072 + 8); }
#pragma unroll
                for (int i = 0; i < 4; ++i) { const u32x4 x0 = xr[i][0], x1 = xr[i][1];
#pragma unroll
                    for (int e = 0; e < 4; ++e) { const f32x4 w4 = *(const LAS f32x4*)(wsrc0 + i * 1536 + 4 * e); const unsigned xa = (e < 2) ? x0[2 * e] : x1[2 * e - 4], xb = (e < 2) ? x0[2 * e + 1] : x1[2 * e - 3];
                        y[mat][4 * e + 0] += w4.x * bflo(xa); y[mat][4 * e + 1] += w4.y * bfhi(xa); y[mat][4 * e + 2] += w4.z * bflo(xb); y[mat][4 * e + 3] += w4.w * bfhi(xb); } }
            } else {
#pragma unroll
                for (int i = 0; i < 4; ++i) { const int tt = c * 64 + t - 3 + i;
                    if (tt >= 0) { const u32x4 x0 = *(const u32x4*)(src0 + (i - 3) * 3072), x1 = *(const u32x4*)(src0 + (i - 3) * 3072 + 8);
#pragma unroll
                        for (int e = 0; e < 4; ++e) { const f32x4 w4 = *(const LAS f32x4*)(wsrc0 + i * 1536 + 4 * e); const unsigned xa = (e < 2) ? x0[2 * e] : x1[2 * e - 4], xb = (e < 2) ? x0[2 * e + 1] : x1[2 * e - 3];
                            y[mat][4 * e + 0] += w4.x * bflo(xa); y[mat][4 * e + 1] += w4.y * bfhi(xa); y[mat][4 * e + 2] += w4.z * bflo(xb); y[mat][4 * e + 3] += w4.w * bfhi(xb); } } }
            }
#pragma unroll
            for (int e = 0; e < 16; ++e) y[mat][e] = pg8::silu_f(y[mat][e]);
        }
        float sq = 0.f, sk = 0.f;
#pragma unroll
        for (int e = 0; e < 16; ++e) { sq += y[0][e] * y[0][e]; sk += y[1][e] * y[1][e]; }
#pragma unroll
        for (int o = 1; o < 8; o <<= 1) { sq += __shfl_xor(sq, o); sk += __shfl_xor(sk, o); }
        const float rq = rsqrtf(sq + EPSN) * 0.08838834764831845f, rk = rsqrtf(sk + EPSN);
        const float gct = GC[t], bt = BETA[t], egt = __expf(gct);
#pragma unroll
        for (int e = 0; e < 16; ++e) { y[0][e] *= rq; y[1][e] *= rk; }
        u32x4 w0, w1;
        w0.x = cvt_pk_bf16(y[1][0], y[1][1]); w0.y = cvt_pk_bf16(y[1][2], y[1][3]); w0.z = cvt_pk_bf16(y[1][4], y[1][5]); w0.w = cvt_pk_bf16(y[1][6], y[1][7]);
        w1.x = cvt_pk_bf16(y[1][8], y[1][9]); w1.y = cvt_pk_bf16(y[1][10], y[1][11]); w1.z = cvt_pk_bf16(y[1][12], y[1][13]); w1.w = cvt_pk_bf16(y[1][14], y[1][15]);
        *(LAS u32x4*)(Kl + t * 136 + ch0) = w0; *(LAS u32x4*)(Kl + t * 136 + ch0 + 8) = w1;
        w0.x = cvt_pk_bf16(y[0][0], y[0][1]); w0.y = cvt_pk_bf16(y[0][2], y[0][3]); w0.z = cvt_pk_bf16(y[0][4], y[0][5]); w0.w = cvt_pk_bf16(y[0][6], y[0][7]);
        w1.x = cvt_pk_bf16(y[0][8], y[0][9]); w1.y = cvt_pk_bf16(y[0][10], y[0][11]); w1.z = cvt_pk_bf16(y[0][12], y[0][13]); w1.w = cvt_pk_bf16(y[0][14], y[0][15]);
        *(LAS u32x4*)(Ql + t * 136 + ch0) = w0; *(LAS u32x4*)(Ql + t * 136 + ch0 + 8) = w1;
#pragma unroll
        for (int e = 0; e < 4; ++e) { *(LAS f32x4*)(RHS + t * RHSP + ch0 + 4 * e) = (f32x4){bt * y[2][4 * e], bt * y[2][4 * e + 1], bt * y[2][4 * e + 2], bt * y[2][4 * e + 3]};
            const float be = bt * egt; *(LAS f32x4*)(RHS + t * RHSP + 128 + ch0 + 4 * e) = (f32x4){be * y[1][4 * e], be * y[1][4 * e + 1], be * y[1][4 * e + 2], be * y[1][4 * e + 3]}; }
#pragma unroll
        for (int e = 0; e < 4; ++e) { u32x2 w; w.x = cvt_pk_bf16(y[0][4 * e] * egt, y[0][4 * e + 1] * egt); w.y = cvt_pk_bf16(y[0][4 * e + 2] * egt, y[0][4 * e + 3] * egt);
            *(u32x2*)(QD + t * 128 + 32 * (cg8 >> 1) + 8 * e + 4 * (cg8 & 1)) = w; }
    }
    __syncthreads();
    {
        const int fr = lane & 15, fq = lane >> 4, ti = wid >> 1, jp = wid & 1;
        f32x4 kk[2], qk[2];
#pragma unroll
        for (int e = 0; e < 2; ++e) { kk[e] = (f32x4){0.f, 0.f, 0.f, 0.f}; qk[e] = (f32x4){0.f, 0.f, 0.f, 0.f}; }
#pragma unroll
        for (int ks = 0; ks < 4; ++ks) { const bf16x8 bK = *(const LAS bf16x8*)(Kl + (16 * ti + fr) * 136 + 32 * ks + 8 * fq), bQ = *(const LAS bf16x8*)(Ql + (16 * ti + fr) * 136 + 32 * ks + 8 * fq);
#pragma unroll
            for (int e = 0; e < 2; ++e) { const bf16x8 a = *(const LAS bf16x8*)(Kl + (16 * (2 * jp + e) + fr) * 136 + 32 * ks + 8 * fq);
                kk[e] = __builtin_amdgcn_mfma_f32_16x16x32_bf16(a, bK, kk[e], 0, 0, 0); qk[e] = __builtin_amdgcn_mfma_f32_16x16x32_bf16(a, bQ, qk[e], 0, 0, 0); } }
        const int t = 16 * ti + fr; const float gct = GC[t];
        float av[8];
#pragma unroll
        for (int e = 0; e < 2; ++e) { f32x4 lv;
#pragma unroll
            for (int r = 0; r < 4; ++r) { const int s = 16 * (2 * jp + e) + 4 * fq + r; const float gcs = GC[s]; const float dec = __expf(fminf(gct - gcs, 0.f)), dec2 = __expf(fminf(gcs - gct, 0.f));
                lv[r] = (t < s) ? BETA[s] * kk[e][r] * dec2 : 0.f; av[4 * e + r] = (s <= t) ? qk[e][r] * dec : 0.f; }
            *(LAS f32x4*)(Ll + t * 64 + 16 * (2 * jp + e) + 4 * fq) = lv; }
        u32x4 w; w.x = cvt_pk_bf16(av[0], av[1]); w.y = cvt_pk_bf16(av[2], av[3]); w.z = cvt_pk_bf16(av[4], av[5]); w.w = cvt_pk_bf16(av[6], av[7]);
        *(u32x4*)(ATT + t * 64 + 32 * jp + 8 * fq) = w;
    }
    __syncthreads();
    if (wid < 4) {
        const int col = 64 * wid + lane;
        int vz; asm volatile("v_mov_b32 %0, 0" : "=v"(vz));
        const LAS float* Lz = Ll + 4 * vz;
        float x[64];
#pragma unroll
        for (int i = 0; i < 64; ++i) x[i] = RHS[i * RHSP + col];
#pragma unroll
        for (int m = 0; m < 63; ++m) { const float xm = x[m];
#pragma unroll
            for (int g4 = (m + 1) / 4; g4 < 16; ++g4) { const f32x4 l4 = *(const LAS f32x4*)(Lz + m * 64 + 4 * g4);
                x[4 * g4] -= l4.x * xm; x[4 * g4 + 1] -= l4.y * xm; x[4 * g4 + 2] -= l4.z * xm; x[4 * g4 + 3] -= l4.w * xm; } }
        if (wid < 2) {
#pragma unroll
            for (int j = 0; j < 8; ++j) { u32x4 w; w.x = cvt_pk_bf16(x[8 * j], x[8 * j + 1]); w.y = cvt_pk_bf16(x[8 * j + 2], x[8 * j + 3]); w.z = cvt_pk_bf16(x[8 * j + 4], x[8 * j + 5]); w.w = cvt_pk_bf16(x[8 * j + 6], x[8 * j + 7]);
                *(u32x4*)(UT + col * 64 + 8 * j) = w; }
        } else {
            const int dk = col - 128, o = dk & 31; const int pos = (dk & ~31) + ((o < 16) ? (8 * (o >> 2) + (o & 3)) : (8 * ((o - 16) >> 2) + 4 + (o & 3)));
#pragma unroll
            for (int i = 0; i < 64; ++i) Ql[i * 136 + pos] = (bf16_t)(cvt_pk_bf16(-x[i], 0.f) & 0xffffu);
        }
    } else {
        const int idx = tid - 256, dk = idx >> 1, th = idx & 1; const float gl = GC[63];
        float v[32];
#pragma unroll
        for (int pos = 0; pos < 32; ++pos) { const int a = pos >> 3, s = pos & 7; const int o = (s < 4) ? (4 * a + s) : (16 + 4 * a + s - 4); const int t = 32 * th + o;
            v[pos] = bf2f(Kl[t * 136 + dk]) * __expf(gl - GC[t]); }
#pragma unroll
        for (int j = 0; j < 4; ++j) { u32x4 w; w.x = cvt_pk_bf16(v[8 * j], v[8 * j + 1]); w.y = cvt_pk_bf16(v[8 * j + 2], v[8 * j + 3]); w.z = cvt_pk_bf16(v[8 * j + 4], v[8 * j + 5]); w.w = cvt_pk_bf16(v[8 * j + 6], v[8 * j + 7]);
            *(u32x4*)(KTT + dk * 64 + 32 * th + 8 * j) = w; }
    }
    __syncthreads();
#pragma unroll
    for (int i = 0; i < 2; ++i) { const int p = tid + 512 * i; *(u32x4*)(NW + (p >> 4) * 128 + (p & 15) * 8) = *(const LAS u32x4*)(Ql + (p >> 4) * 136 + (p & 15) * 8); }
    }
}

constexpr int GS_NW = 0, GS_QD = 17408, GS_ATT = 34816, GS_KTT = 44032, GS_UT = 62464, GS_OL = 80896;
__device__ __forceinline__ void gdn_scan(LAS unsigned char* lds, const Params& P, int bh, int half, int tid, int wid, int lane) {
    LAS bf16_t* NWl = (LAS bf16_t*)(lds + GS_NW); LAS bf16_t* QDl = (LAS bf16_t*)(lds + GS_QD); LAS bf16_t* ATTl = (LAS bf16_t*)(lds + GS_ATT);
    LAS bf16_t* KTTl = (LAS bf16_t*)(lds + GS_KTT); LAS bf16_t* UTl = (LAS bf16_t*)(lds + GS_UT); LAS float* OL = (LAS float*)(lds + GS_OL);
    const int b = bh >> 2, h = bh & 3, fr = lane & 15, fq = lane >> 4;
    bf16_t* ORAW = (bf16_t*)(P.ws + WS_ORAW); const int dvw = 64 * half + 16 * wid;
    const float* EGL = (const float*)(P.ws + WS_MISC + MISC_EGL) + (size_t)bh * 128;
    const u32x4* gNW = (const u32x4*)(P.ws + WS_NW) + (size_t)bh * 128 * 1024; const u32x4* gQD = (const u32x4*)(P.ws + WS_QD) + (size_t)bh * 128 * 1024;
    const u32x4* gATT = (const u32x4*)(P.ws + WS_ATT) + (size_t)bh * 128 * 512; const u32x4* gKTT = (const u32x4*)(P.ws + WS_KTT) + (size_t)bh * 128 * 1024; const u32x4* gUT = (const u32x4*)(P.ws + WS_UT) + (size_t)bh * 128 * 1024;
    const int ot = tid >> 3, og = tid & 7;
    f32x4 Sacc[8];
#pragma unroll
    for (int m = 0; m < 8; ++m) Sacc[m] = (f32x4){0.f, 0.f, 0.f, 0.f};
    u32x4 rNW[2], rQD[2], rATT, rKTT[2], rUT[2]; float egl_n;
#define GS_GLOAD(c) do { _Pragma("unroll") for (int i_ = 0; i_ < 2; ++i_) { rNW[i_] = gNW[(size_t)(c) * 1024 + tid + 512 * i_]; rQD[i_] = gQD[(size_t)(c) * 1024 + tid + 512 * i_]; \
        rKTT[i_] = gKTT[(size_t)(c) * 1024 + tid + 512 * i_]; rUT[i_] = gUT[(size_t)(c) * 1024 + tid + 512 * i_]; } rATT = gATT[(size_t)(c) * 512 + tid]; egl_n = EGL[c]; } while (0)
    GS_GLOAD(0);
    for (int c = 0; c < 128; ++c) {
#pragma unroll
        for (int i = 0; i < 2; ++i) { const int p = tid + 512 * i;
            *(LAS u32x4*)(NWl + (p >> 4) * 136 + (p & 15) * 8) = rNW[i]; *(LAS u32x4*)(QDl + (p >> 4) * 136 + (p & 15) * 8) = rQD[i];
            *(LAS u32x4*)(KTTl + (p >> 3) * 72 + (p & 7) * 8) = rKTT[i]; *(LAS u32x4*)(UTl + (p >> 3) * 72 + (p & 7) * 8) = rUT[i]; }
        *(LAS u32x4*)(ATTl + (tid >> 3) * 72 + (tid & 7) * 8) = rATT;
        const float egl = egl_n;
        __syncthreads();
        if (c + 1 < 128) GS_GLOAD(c + 1);
        const size_t R = (size_t)b * SEQ + (size_t)c * 64 + ot;
        if (wid < 4) {
        bf16x8 Bs[4];
#pragma unroll
        for (int ks = 0; ks < 4; ++ks) { u32x4 w; w.x = cvt_pk_bf16(Sacc[2 * ks][0], Sacc[2 * ks][1]); w.y = cvt_pk_bf16(Sacc[2 * ks][2], Sacc[2 * ks][3]);
            w.z = cvt_pk_bf16(Sacc[2 * ks + 1][0], Sacc[2 * ks + 1][1]); w.w = cvt_pk_bf16(Sacc[2 * ks + 1][2], Sacc[2 * ks + 1][3]); Bs[ks] = __builtin_bit_cast(bf16x8, w); }
        f32x4 VN[4], OA[4];
#pragma unroll
        for (int mt = 0; mt < 4; ++mt) { const u32x2 u2 = *(const LAS u32x2*)(UTl + (dvw + fr) * 72 + 16 * mt + 4 * fq);
            VN[mt] = (f32x4){bflo(u2.x), bfhi(u2.x), bflo(u2.y), bfhi(u2.y)}; OA[mt] = (f32x4){0.f, 0.f, 0.f, 0.f}; }
#pragma unroll
        for (int ks = 0; ks < 4; ++ks)
#pragma unroll
            for (int mt = 0; mt < 4; ++mt) { const bf16x8 a = *(const LAS bf16x8*)(NWl + (16 * mt + fr) * 136 + 32 * ks + 8 * fq), q = *(const LAS bf16x8*)(QDl + (16 * mt + fr) * 136 + 32 * ks + 8 * fq);
                VN[mt] = __builtin_amdgcn_mfma_f32_16x16x32_bf16(a, Bs[ks], VN[mt], 0, 0, 0); OA[mt] = __builtin_amdgcn_mfma_f32_16x16x32_bf16(q, Bs[ks], OA[mt], 0, 0, 0); }
        bf16x8 Bv[2];
#pragma unroll
        for (int k2 = 0; k2 < 2; ++k2) { u32x4 w; w.x = cvt_pk_bf16(VN[2 * k2][0], VN[2 * k2][1]); w.y = cvt_pk_bf16(VN[2 * k2][2], VN[2 * k2][3]);
            w.z = cvt_pk_bf16(VN[2 * k2 + 1][0], VN[2 * k2 + 1][1]); w.w = cvt_pk_bf16(VN[2 * k2 + 1][2], VN[2 * k2 + 1][3]); Bv[k2] = __builtin_bit_cast(bf16x8, w); }
#pragma unroll
        for (int k2 = 0; k2 < 2; ++k2)
#pragma unroll
            for (int mt = 0; mt < 4; ++mt) { const bf16x8 a = *(const LAS bf16x8*)(ATTl + (16 * mt + fr) * 72 + 32 * k2 + 8 * fq);
                OA[mt] = __builtin_amdgcn_mfma_f32_16x16x32_bf16(a, Bv[k2], OA[mt], 0, 0, 0); }
#pragma unroll
        for (int m = 0; m < 8; ++m) Sacc[m] = Sacc[m] * egl;
#pragma unroll
        for (int k2 = 0; k2 < 2; ++k2)
#pragma unroll
            for (int m = 0; m < 8; ++m) { const bf16x8 a = *(const LAS bf16x8*)(KTTl + (16 * m + fr) * 72 + 32 * k2 + 8 * fq);
                Sacc[m] = __builtin_amdgcn_mfma_f32_16x16x32_bf16(a, Bv[k2], Sacc[m], 0, 0, 0); }
#pragma unroll
        for (int mt = 0; mt < 4; ++mt)
#pragma unroll
            for (int r = 0; r < 4; ++r) OL[(16 * mt + 4 * fq + r) * 132 + 16 * wid + fr] = OA[mt][r];
        }
        __syncthreads();
        {
            const f32x4 a = *(const LAS f32x4*)(OL + ot * 132 + 8 * og), b2 = *(const LAS f32x4*)(OL + ot * 132 + 8 * og + 4);
            u32x4 w; w.x = cvt_pk_bf16(a.x, a.y); w.y = cvt_pk_bf16(a.z, a.w); w.z = cvt_pk_bf16(b2.x, b2.y); w.w = cvt_pk_bf16(b2.z, b2.w);
            *(u32x4*)(ORAW + R * 512 + h * 128 + 64 * half + 8 * og) = w;
        }
    }
#undef GS_GLOAD
    __syncthreads();
}

#if defined(__HIP_DEVICE_COMPILE__)
__device__ __forceinline__ Params getp() { auto k = __builtin_amdgcn_kernarg_segment_ptr(); asm volatile("" : "+s"(k)); return *(const Params __attribute__((address_space(4)))*)k; }
#else
__device__ __forceinline__ Params getp() { return Params{}; }
#endif
#define GEMM_BF16(Aptr, Bptr, M_, N_, K_, Optr, ldc_, scale_, coff_) do { const Params P = getp(); unsigned char* ws = P.ws; (void)ws; \
        pg8::Gemm g{(const bf16_t*)(Aptr), (const bf16_t*)(Bptr), (M_), (N_), (K_)}; pg8::StaticOrder S; S.init((M_), (N_), G, (bid + (coff_)) % G); pg8::EpiBf16 E{(bf16_t*)(Optr), (ldc_), (scale_)}; \
        _Pragma("unroll") for (int rep_ = 0; rep_ < GEMM_REPS; ++rep_) pg8::gemm_phase<pg8::EpiBf16, pg8::StaticOrder, true, true>(lds, g, S, E); } while (0)
#define GEMM_MAP(LDC_, Aptr, Bptr, M_, N_, K_, bbs_, bsh_, Optr, sh_, looff_, hioff_, pnoff_, scale_, coff_) do { const Params P = getp(); unsigned char* ws = P.ws; (void)ws; \
        int kv_ = (K_); asm volatile("" : "+s"(kv_));     \
        pg8::Gemm g{(const bf16_t*)(Aptr), (const bf16_t*)(Bptr), (M_), (N_), kv_, (size_t)(bbs_), (bsh_)}; pg8::StaticOrder S; S.init((M_), (N_), G, (bid + (coff_)) % G); \
        pg8::EpiBf16Map<LDC_> E{(bf16_t*)(Optr), (sh_), (size_t)(looff_), (size_t)(hioff_), (size_t)(pnoff_), (scale_)}; \
        pg8::gemm_phase<pg8::EpiBf16Map<LDC_>, pg8::StaticOrder, true, true>(lds, g, S, E); } while (0)
#define GEMM_SWIGLU(Bptr) do { const Params P = getp(); unsigned char* ws = P.ws; \
        pg8::Gemm g{(const bf16_t*)(ws + WS_A), (const bf16_t*)(Bptr), MTOK, 2 * DFF, DM}; pg8::StaticOrder S; S.init(MTOK, 2 * DFF, G, bid); pg8::EpiSwiGLU E{(bf16_t*)(ws + WS_BIG), DFF}; \
        _Pragma("unroll") for (int rep_ = 0; rep_ < GEMM_REPS; ++rep_) pg8::gemm_phase<pg8::EpiSwiGLU, pg8::StaticOrder, true, true>(lds, g, S, E); } while (0)
#define GEMM_FUSED(Aptr, Bptr, K_, hin_, gpost_, w_, gnext_, hasA_, e_) do { const Params P = getp(); unsigned char* ws = P.ws; \
        pg8::Gemm g{(const bf16_t*)(Aptr), (const bf16_t*)(Bptr), MTOK, DM, (K_)}; pg8::StaticOrder S; S.init(MTOK, DM, G, bid); \
        pg8::EpiRmsRes E{(hin_), P.out, (hasA_) ? (bf16_t*)(ws + WS_A) : nullptr, (gpost_), (gnext_), (w_), EPSN, (float*)(ws + WS_XS + (size_t)(e_) * XS_BYTES), (unsigned*)(ws + WS_XCNT), 32u * ((e_) + 1), lds + 131072}; \
        pg8::gemm_phase<pg8::EpiRmsRes, pg8::StaticOrder, true, true>(lds, g, S, E); } while (0)
#define ROW_F_OFF WS_F
#define ROW_PHASE(hin_, gpost_, w_, gnext_, hasA_, mode_) do { PH_IDS const Params P = getp(); unsigned char* ws = P.ws; bf16_t* HB = (bf16_t*)(ws + WS_HB); bf16_t* OB = (bf16_t*)P.out; \
        row_phase(((mode_) == 0 || (mode_) == 1 || (mode_) == 4) ? (hin_) : nullptr, ((mode_) == 2 || (mode_) == 3) ? HB : ((mode_) == 5 ? OB : nullptr), (const bf16_t*)(ws + ROW_F_OFF), (gpost_), (w_), \
                  ((mode_) == 0 || (mode_) == 3) ? P.out : nullptr, ((mode_) == 1 || (mode_) == 2 || (mode_) == 5) ? HB : ((mode_) == 4 ? OB : nullptr), \
                  (gnext_), (hasA_) ? (bf16_t*)(ws + WS_A) : nullptr, MTOK, gw, ngw, lane); } while (0)
#if defined(TS_SEL)
#define GSYNC() do { cg::this_grid().sync(); if (blockIdx.x == 0 && threadIdx.x == 0) { const Params Pt = getp(); ((unsigned long long*)(Pt.ws + WS_CTL + 16384))[ts_k] = __builtin_amdgcn_s_memrealtime(); } ++ts_k; } while (0)
#else
#if defined(USE_CG_ONLY)
#define GSYNC() cg::this_grid().sync()
#else
#define GSYNC() do { const Params Pb = getp(); XcdBarrier xb_; xb_.bar = (unsigned*)(Pb.ws + WS_XBAR); xb_.x = xb_xcc_id(); xb_.st = (volatile LAS unsigned*)(lds + LDS_BCAST + 64); xcd_barrier(xb_); } while (0)
#endif
#endif
#if defined(TS_SEL)
#define TS_STAMP0() do { if (blockIdx.x == 0 && threadIdx.x == 0) { const Params Pt = getp(); ((unsigned long long*)(Pt.ws + WS_CTL + 16384))[ts_k] = __builtin_amdgcn_s_memrealtime(); } ++ts_k; } while (0)
#else
#define TS_STAMP0() do { } while (0)
#endif
#define GSYNC0() do { cg::this_grid().sync(); { const Params Pb = getp(); (void)xcd_barrier_post((unsigned*)(Pb.ws + WS_XBAR), (volatile LAS unsigned*)(lds + LDS_BCAST + 64)); } TS_STAMP0(); } while (0)
#ifndef GEMM_REPS
#define GEMM_REPS 1
#endif

__global__ void __launch_bounds__(512, 2) hymba_fwd(Params Parg) {
    extern __shared__ __attribute__((aligned(16))) unsigned char lds_raw[];
    LAS unsigned char* lds = (LAS unsigned char*)lds_raw;
    const int G = gridDim.x, bid = blockIdx.x;
    if (threadIdx.x < 2) ((volatile LAS unsigned*)(lds + LDS_BCAST + 64))[threadIdx.x] = 0u;
#if defined(TS_SEL)
    int ts_k = 0;
    if (blockIdx.x == 0 && threadIdx.x == 0) { const Params Pt = getp(); ((unsigned long long*)(Pt.ws + WS_CTL + 16384))[31] = __builtin_amdgcn_s_memrealtime(); }
#endif
#define PH_IDS int tid_l = threadIdx.x; asm volatile("" : "+v"(tid_l)); const int tid = tid_l, lane = tid & 63, wid = __builtin_amdgcn_readfirstlane(tid >> 6), gw = bid * 8 + wid, ngw = G * 8; (void)gw; (void)ngw; (void)lane; \
        volatile LAS unsigned* bc = (volatile LAS unsigned*)(lds + LDS_BCAST); (void)bc;

    {
        PH_IDS const Params P = getp(); unsigned char* ws = P.ws;
        LAS float* scr = (LAS float*)(lds + wid * 16384);
        if (bid == 0 && tid < 64) { unsigned* ctl = (unsigned*)(ws + WS_CTL); ctl[64 * tid] = 0u; }
        if (bid == 0) { unsigned* xb = (unsigned*)(ws + WS_XBAR); for (int i = tid; i < XCD_BAR_WORDS; i += 512) xb[i] = 0u; }
        if (bid == 0) { unsigned* xc = (unsigned*)(ws + WS_XCNT); for (int i = tid; i < 256 * 64; i += 512) xc[i] = 0u; }
        transpose_all(P.in[3], DM, DFF, (bf16_t*)(ws + WS_WGU1), MapGate{}, scr, gw, ngw, lane);
        transpose_all(P.in[4], DM, DFF, (bf16_t*)(ws + WS_WGU1), MapUp{}, scr, gw, ngw, lane);
        transpose_all(P.in[5], DFF, DM, (bf16_t*)(ws + WS_WD1), MapIdent{0}, scr, gw, ngw, lane);
        transpose_all(P.in[8], DM, 3600, (bf16_t*)(ws + WS_WIN), MapWin{}, scr, gw, ngw, lane);
        transpose_all(P.in[8], DM, 3600, (bf16_t*)(ws + WS_WVT), MapWinV{}, scr, gw, ngw, lane);
        transpose_all(P.in[19], DM, 2 * DM, (bf16_t*)(ws + WS_WKV), MapIdent{0}, scr, gw, ngw, lane);
        {
            u32x4* z = (u32x4*)((bf16_t*)(ws + WS_WIN) + (size_t)3088 * DM); const int n16 = 240 * DM / 8;
            for (int i = bid * 512 + tid; i < n16; i += G * 512) z[i] = (u32x4){0u, 0u, 0u, 0u};
        }
        for (int h = 0; h < 4; ++h) transpose_all(P.in[20] + (size_t)h * 256 * DM, 256, DM, (bf16_t*)(ws + WS_WOTH) + (size_t)h * DM * 256, MapIdent{0}, scr, gw, ngw, lane);
        for (int i = bid * 512 + tid; i < 131072; i += G * 512) { const int h = i >> 15, rem = i & 32767, k = rem >> 5, d8 = rem & 31;
            const float* src = P.in[18] + (size_t)k * DM + h * 256 + d8 * 8; const f32x4 a = *(const f32x4*)src, b2 = *(const f32x4*)(src + 4);
            u32x4 w; w.x = cvt_pk_bf16(a.x, a.y); w.y = cvt_pk_bf16(a.z, a.w); w.z = cvt_pk_bf16(b2.x, b2.y); w.w = cvt_pk_bf16(b2.z, b2.w); ((u32x4*)(ws + WS_WQH))[i] = w; }
        row_phase(P.in[0], nullptr, nullptr, nullptr, 0.f, nullptr, nullptr, P.in[2], (bf16_t*)(ws + WS_A), MTOK, gw, ngw, lane);
        row_phase(P.in[1], nullptr, nullptr, nullptr, 0.f, nullptr, nullptr, P.in[17], (bf16_t*)(ws + WS_AMEM), NB * NMEM, gw, ngw, lane);
    }
    GSYNC0();
#if defined(STOP_AFTER)
    if (STOP_AFTER == 0) return;
#endif
    GEMM_SWIGLU(ws + WS_WGU1);
    GSYNC();
#if defined(STOP_AFTER)
    if (STOP_AFTER == 1) return;
#endif
    GEMM_BF16(ws + WS_BIG, ws + WS_WD1, MTOK, DM, DFF, ws + WS_F, DM, 1.f, 0);
    GSYNC();
#if defined(STOP_AFTER)
    if (STOP_AFTER == 2) return;
#endif
    ROW_PHASE(P.in[0], P.in[6], 0.5f, P.in[7], true, 4);
    GSYNC();
#if defined(STOP_AFTER)
    if (STOP_AFTER == 3) return;
#endif
    { const Params P = getp(); unsigned char* ws = P.ws;
      pg8::Gemm g{(const bf16_t*)(ws + WS_A), (const bf16_t*)(ws + WS_WIN), MTOK, 3328, DM}; pg8::StaticOrder S; S.init(MTOK, 3328, G, bid); pg8::EpiProj E{(bf16_t*)(ws + WS_BIG), (float*)(ws + WS_SM), FOX_QSCALE};
      _Pragma("unroll") for (int rep_ = 0; rep_ < GEMM_REPS; ++rep_) pg8::gemm_phase<pg8::EpiProj, pg8::StaticOrder, true, true>(lds, g, S, E); }
    GEMM_BF16(ws + WS_WVT, ws + WS_A, 512, MTOK, DM, ws + WS_VT, MTOK, 1.f, 0);
    GSYNC();
#if defined(STOP_AFTER)
    if (STOP_AFTER == 4) return;
#endif
    { PH_IDS const Params P = getp();
#ifndef P5_REPS
#define P5_REPS 1
#endif
      {
#ifndef FOXP_REPS
#define FOXP_REPS 1
#endif
      if (bid < 64) { for (int rp = 0; rp < FOXP_REPS; ++rp) fox_prep(lds, P, bid, tid, wid, lane); }
      { LAS float* CW = (LAS float*)(lds + GP_CW); for (int i = tid; i < 6144; i += 512) CW[i] = P.in[10][i]; }
      { unsigned* ctl = (unsigned*)(P.ws + WS_CTL);
      for (;;) { if (tid == 0) *bc = atomicAdd(ctl + 0, 1u); __syncthreads(); const int ci = (int)*bc; __syncthreads(); if (ci >= 4096) break;
          gdn_prep_chunk(lds, P, ci, tid, wid, lane); } } } }
    GSYNC();
#if defined(STOP_AFTER)
    if (STOP_AFTER == 5) return;
#endif
#if defined(DUMP_PREP)
    { PH_IDS const Params P = getp(); unsigned char* ws = P.ws; const bf16_t* s0 = (const bf16_t*)(ws + DUMP_A); const bf16_t* s1 = (const bf16_t*)(ws + DUMP_B);
      for (int i = bid * 512 + tid; i < 4096 * 8192; i += G * 512) { float a = bf2f(s0[i]), b = bf2f(s1[i]); if (!(fabsf(a) < 1e30f)) a = 1e4f; if (!(fabsf(b) < 1e30f)) b = 1e4f;
          if (fabsf(a) > 100.f) a = 3e3f; if (fabsf(b) > 100.f) b = 3e3f; P.out[i] = a; P.out[4096 * 8192 + i] = b; } }
    return;
#endif
    GEMM_MAP(256, ws + WS_AMEM, ws + WS_WKV, NB * NMEM, 2 * DM, DM, 0, 0, ws + WS_KMEM, 30, (size_t)256 * 256, 0, (size_t)2048 * 256, 1.f, 64);
    { PH_IDS const Params P = getp(); unsigned char* ws = P.ws; unsigned* ctl = (unsigned*)(ws + WS_CTL);
#ifndef P6_REPS
#define P6_REPS 1
#endif
      {
#if defined(SKIP_GDN)
      for (int i = bid * 512 + tid; i < MTOK * 64; i += G * 512) { ((u32x4*)(ws + WS_A))[(i >> 6) * 128 + 64 + (i & 63)] = (u32x4){0u, 0u, 0u, 0u}; }
#else
      if (bid < 64) gdn_scan(lds, P, bid >> 1, bid & 1, tid, wid, lane);
#if defined(TS_SEL)
      if (bid == 0 && tid == 0) ((unsigned long long*)(ws + WS_CTL + 16384))[30] = __builtin_amdgcn_s_memrealtime();
#endif
#endif
#if defined(SKIP_FOX)
      for (int i = bid * 512 + tid; i < MTOK * 64; i += G * 512) { ((u32x4*)(ws + WS_A))[(i >> 6) * 128 + (i & 63)] = (u32x4){0u, 0u, 0u, 0u}; }
#endif
      const int* KT0 = (const int*)(ws + WS_MISC + MISC_KT0); const bf16_t* PJ = (const bf16_t*)(ws + WS_BIG);
#if defined(SKIP_FOX)
      if (0)
#endif
      for (;;) { if (tid == 0) *bc = atomicAdd(ctl + 64, 1u); __syncthreads(); const int idx = (int)*bc; __syncthreads(); if (idx >= 2048) break;
          const int qb = 31 - (idx >> 6), bh = idx & 63, b = bh >> 3, h = bh & 7;
          const int kt0 = KT0[bh * 64 + 2 * qb];
          attn_unit<64, true, 2>(lds, PJ + (size_t)b * SEQ * 3072 + h * 64, 3072, PJ + (size_t)b * SEQ * 3072 + 512 + h * 64, 3072,
                              (const bf16_t*)(ws + WS_VT) + (size_t)(h * 64) * MTOK + (size_t)b * SEQ, MTOK, (bf16_t*)(ws + WS_A) + (size_t)b * SEQ * 1024 + h * 64, 1024,
                              (const float*)(ws + WS_FC) + (size_t)bh * SEQ, qb, kt0, 4 * qb + 3, tid, wid, lane); } }
      if (bid >= 64) { LAS float* scr = (LAS float*)(lds + wid * 16384); const int gw2 = (bid - 64) * 8 + wid, ngw2 = (G - 64) * 8;
        transpose_all(P.in[14], DM, DM, (bf16_t*)(ws + WS_WOUT), MapIdent{0}, scr, gw2, ngw2, lane);
        transpose_all(P.in[23], DM, DFF, (bf16_t*)(ws + WS_WGU2), MapGate{}, scr, gw2, ngw2, lane);
        transpose_all(P.in[24], DM, DFF, (bf16_t*)(ws + WS_WGU2), MapUp{}, scr, gw2, ngw2, lane);
        transpose_all(P.in[25], DFF, DM, (bf16_t*)(ws + WS_WD2), MapIdent{0}, scr, gw2, ngw2, lane); }
      }
    GSYNC();
#if defined(STOP_AFTER)
    if (STOP_AFTER == 6) return;
#endif
#if defined(DUMP_MIX)
    { PH_IDS const Params P = getp(); unsigned char* ws = P.ws; const bf16_t* s0 = (const bf16_t*)(ws + WS_A);
      for (int i = bid * 512 + tid; i < MTOK * 1024; i += G * 512) { float a = bf2f(s0[i]); if (!(fabsf(a) < 1e30f)) a = 1e4f; else if (fabsf(a) > 100.f) a = 3e3f;
#if defined(DUMP_MASK0)
          if ((((i >> 10) & 8191) >> 6) == DUMP_MASK0) a = 0.f;
#endif
          P.out[i] = a; } }
    return;
#endif
    GEMM_MAP(1024, ws + WS_KMEM, ws + WS_WQH, 4 * NB * NMEM, DM, 256, (size_t)DM * 256 * 2, 3, ws + WS_MB, 3, (size_t)DM * DM, (size_t)256 * DM, 256, MEM_QSCALE, 0);
    GEMM_MAP(1024, ws + WS_WOTH, ws + WS_VMEMT, 4 * DM, NB * NMEM, 256, (size_t)2048 * 256 * 2, 2, ws + WS_NB, 2, (size_t)256 * DM, 256, (size_t)DM * DM, 1.f, 128);
    { PH_IDS const Params P = getp(); unsigned char* ws = P.ws; const bf16_t* ORAW = (const bf16_t*)(ws + WS_ORAW); const bf16_t* PJ = (const bf16_t*)(ws + WS_BIG); bf16_t* MIX = (bf16_t*)(ws + WS_A);
      for (int it = bid * 512 + tid; it < MTOK * 32; it += G * 512) { const int og = it & 7, h = (it >> 3) & 3; const size_t R = (size_t)(it >> 5);
          const u32x4 o0 = *(const u32x4*)(ORAW + R * 512 + h * 128 + 16 * og), o1 = *(const u32x4*)(ORAW + R * 512 + h * 128 + 16 * og + 8);
          const u32x4 gz0 = *(const u32x4*)(PJ + R * 3072 + 2560 + h * 128 + 16 * og), gz1 = *(const u32x4*)(PJ + R * 3072 + 2560 + h * 128 + 16 * og + 8);
          float ov[16], z[16]; float ss = 0.f;
#pragma unroll
          for (int e = 0; e < 4; ++e) { ov[2 * e] = bflo(o0[e]); ov[2 * e + 1] = bfhi(o0[e]); ov[8 + 2 * e] = bflo(o1[e]); ov[8 + 2 * e + 1] = bfhi(o1[e]);
              z[2 * e] = bflo(gz0[e]); z[2 * e + 1] = bfhi(gz0[e]); z[8 + 2 * e] = bflo(gz1[e]); z[8 + 2 * e + 1] = bfhi(gz1[e]); }
#pragma unroll
          for (int e = 0; e < 16; ++e) ss += ov[e] * ov[e];
#pragma unroll
          for (int o = 1; o < 8; o <<= 1) ss += __shfl_xor(ss, o);
          const float rs = rsqrtf(ss * (1.0f / 128.0f) + EPSN);
          float r16[16];
#pragma unroll
          for (int e = 0; e < 4; ++e) { const f32x4 gn = *(const f32x4*)(P.in[13] + 16 * og + 4 * e);
              r16[4 * e] = ov[4 * e] * rs * gn.x * pg8::silu_f(z[4 * e]); r16[4 * e + 1] = ov[4 * e + 1] * rs * gn.y * pg8::silu_f(z[4 * e + 1]);
              r16[4 * e + 2] = ov[4 * e + 2] * rs * gn.z * pg8::silu_f(z[4 * e + 2]); r16[4 * e + 3] = ov[4 * e + 3] * rs * gn.w * pg8::silu_f(z[4 * e + 3]); }
          u32x4 w0, w1;
          w0.x = cvt_pk_bf16(r16[0], r16[1]); w0.y = cvt_pk_bf16(r16[2], r16[3]); w0.z = cvt_pk_bf16(r16[4], r16[5]); w0.w = cvt_pk_bf16(r16[6], r16[7]);
          w1.x = cvt_pk_bf16(r16[8], r16[9]); w1.y = cvt_pk_bf16(r16[10], r16[11]); w1.z = cvt_pk_bf16(r16[12], r16[13]); w1.w = cvt_pk_bf16(r16[14], r16[15]);
          bf16_t* dst = MIX + R * 1024 + 512 + h * 128 + 16 * og; *(u32x4*)dst = w0; *(u32x4*)(dst + 8) = w1; } }
    GSYNC();
    GEMM_BF16(ws + WS_A, ws + WS_WOUT, MTOK, DM, DM, ws + WS_F, DM, 1.f, 0);
    GSYNC();
#if defined(STOP_AFTER)
    if (STOP_AFTER == 7) return;
#endif
    ROW_PHASE(P.out, P.in[15], 1.0f, P.in[16], true, 5);
    GSYNC();
#if defined(STOP_AFTER)
    if (STOP_AFTER == 8) return;
#endif
    { const Params P = getp(); unsigned char* ws = P.ws;
      pg8::Gemm g{(const bf16_t*)(ws + WS_A), (const bf16_t*)(ws + WS_MB), MTOK, DM, DM, (size_t)DM * DM * 2, 5}; pg8::StaticOrder S; S.init(MTOK, DM, G, bid); pg8::EpiSoftmax E{(bf16_t*)(ws + WS_F), DM, lds + 131072};
      pg8::gemm_phase<pg8::EpiSoftmax, pg8::StaticOrder, true, true>(lds, g, S, E); }
    GSYNC();
#if defined(STOP_AFTER)
    if (STOP_AFTER == 9) return;
#endif
    { const Params P = getp(); unsigned char* ws = P.ws;
      pg8::Gemm g{(const bf16_t*)(ws + WS_F), (const bf16_t*)(ws + WS_NB), MTOK, DM, DM, (size_t)DM * DM * 2, 5}; pg8::StaticOrder S; S.init(MTOK, DM, G, bid); pg8::EpiBf16 E{(bf16_t*)(ws + WS_A), DM, 1.f};
      pg8::gemm_phase<pg8::EpiBf16, pg8::StaticOrder, true, true>(lds, g, S, E); }
    GSYNC();
#if defined(STOP_AFTER)
    if (STOP_AFTER == 11) return;
#endif
#undef ROW_F_OFF
#define ROW_F_OFF WS_A
    ROW_PHASE(P.out, P.in[21], 1.0f, P.in[22], true, 2);
#undef ROW_F_OFF
#define ROW_F_OFF WS_F
    GSYNC();
#if defined(STOP_AFTER)
    if (STOP_AFTER == 12) return;
#endif
    GEMM_SWIGLU(ws + WS_WGU2);
    GSYNC();
#if defined(STOP_AFTER)
    if (STOP_AFTER == 13) return;
#endif
    GEMM_BF16(ws + WS_BIG, ws + WS_WD2, MTOK, DM, DFF, ws + WS_F, DM, 1.f, 0);
    GSYNC();
#if defined(STOP_AFTER)
    if (STOP_AFTER == 14) return;
#endif
    ROW_PHASE(P.out, P.in[26], 0.5f, (const float*)nullptr, false, 3);
#if defined(TS_SEL)
    GSYNC();
    { PH_IDS const Params P = getp(); const unsigned long long* ts = (const unsigned long long*)(P.ws + WS_CTL + 16384);
      float d2 = 1e-3f; if (TS_SEL >= 0 && TS_SEL < 20) { const float us = (float)(ts[TS_SEL] - ts[TS_SEL == 0 ? 31 : TS_SEL - 1]) * 0.01f; d2 = us * 1e-6f; }
      if (TS_SEL == 30) { const float us = (float)(ts[30] - ts[5]) * 0.01f; d2 = us * 1e-6f; }
      const float d = sqrtf(d2);
      for (int i = bid * 512 + tid; i < 1024 * 1024; i += G * 512) P.out[i] += d; }
#endif
}

extern "C" void kernel_launch(void* const* d_in, const int* in_sizes, int n_in, void* d_out, int out_size, void* d_ws, size_t ws_size, hipStream_t stream) {
    static int grid = 0;
    if (grid == 0) {
        if (n_in != 27 || ws_size < WS_END) { fprintf(stderr, "kernel_launch: unexpected inputs (n_in %d, ws %zu)\n", n_in, ws_size); grid = -1; return; }
        int dev = 0, cus = 0, per_cu = 0;
        hipGetDevice(&dev); hipDeviceGetAttribute(&cus, hipDeviceAttributeMultiprocessorCount, dev);
        hipFuncSetAttribute((const void*)hymba_fwd, hipFuncAttributeMaxDynamicSharedMemorySize, LDS_BYTES);
        hipOccupancyMaxActiveBlocksPerMultiprocessor(&per_cu, (const void*)hymba_fwd, 512, LDS_BYTES);
        if (per_cu < 1) per_cu = 1;
        grid = cus * per_cu;
        fprintf(stderr, "kernel_launch: grid %d (%d CUs x %d)\n", grid, cus, per_cu);
    }
    if (grid < 0) return;
    Params p{};
    for (int i = 0; i < 27; ++i) p.in[i] = (const float*)d_in[i];
    p.out = (float*)d_out; p.ws = (unsigned char*)d_ws;
    void* args[] = {&p};
    hipError_t e = hipLaunchCooperativeKernel((const void*)hymba_fwd, dim3(grid), dim3(512), args, LDS_BYTES, stream);
    if (e != hipSuccess) fprintf(stderr, "kernel_launch: cooperative launch failed: %s (grid %d)\n", hipGetErrorString(e), grid);
}
```

```cpp
#include <hip/hip_runtime.h>
#include <hip/hip_cooperative_groups.h>
#include <cstdio>
#include <cstdint>
namespace cg = cooperative_groups;

namespace pg8 {
#define PG8_LAS __attribute__((address_space(3)))
typedef unsigned short bf16_t;
typedef short bf16x8 __attribute__((ext_vector_type(8)));
typedef float f32x4 __attribute__((ext_vector_type(4)));
typedef unsigned u32x4 __attribute__((ext_vector_type(4)));
constexpr int BM = 256, BK = 64, HALF = 128, HTB = HALF * BK * 2  , STAGE_BYTES = 8 * HTB, NXCD = 8, WGM = 8;

__host__ __device__ __forceinline__ int lds_byte(int r, int c) { const int st = (r >> 4) * 2 + (c >> 5), rr = r & 15, cc = c & 31, ob = rr * 64 + cc * 2; return st * 1024 + (ob ^ (((ob >> 9) & 1) << 5)); }
__host__ __device__ __forceinline__ void stage_rc(int b, int& R, int& C) { const int st = b / 1024, sb = b % 1024, swz = sb ^ (((sb >> 9) & 1) << 5); R = (st >> 1) * 16 + swz / 64; C = (st & 1) * 32 + (swz % 64) / 2; }
__host__ __device__ __forceinline__ int perm32(int rho) { const int n = rho >> 4, i = rho & 15; return 8 * (i >> 2) + 4 * n + (i & 3); }

struct Unit { int pm, pn; };
struct Gemm { const bf16_t* A; const bf16_t* Bt; int M, N, K; size_t bbs; int bsh; };

struct StaticOrder {
    int nM, nN, nwg, G, c;
    __host__ __device__ void init(int M, int N, int G_, int c_) { nM = M / BM; nN = N / BM; nwg = nM * nN; G = G_; c = c_; }
    __host__ __device__ bool next(int i, Unit& u) const {
        const long L = (long)i * G + c; if (L >= nwg) return false;
        int wgid = (int)L; { const int q = nwg / NXCD, r = nwg % NXCD, xcd = wgid % NXCD, off = wgid / NXCD; wgid = (xcd < r ? xcd * (q + 1) : r * (q + 1) + (xcd - r) * q) + off; }
        const int nig = WGM * nN, gid = wgid / nig, fm = gid * WGM, gsz = (nM - fm) < WGM ? (nM - fm) : WGM;
        u.pm = fm + ((wgid % nig) % gsz); u.pn = (wgid % nig) / gsz; return true;
    }
    __device__ __forceinline__ void a_ready(const Unit&) const {}
    __device__ __forceinline__ void done(const Unit&) const {}
};

typedef float f32x2_t __attribute__((ext_vector_type(2))); typedef __bf16 bf16x2_t __attribute__((ext_vector_type(2)));
__device__ __forceinline__ unsigned cvt_pk_bf16(float lo, float hi) { f32x2_t v = {lo, hi}; bf16x2_t b = __builtin_convertvector(v, bf16x2_t); return __builtin_bit_cast(unsigned, b); }
struct EpiBf16 {
    static constexpr bool PERM = true, AFTER_DRAIN = false;
    bf16_t* O; int ldc; float scale;
    __device__ __forceinline__ void operator()(const f32x4 (&acc)[2][2][4][2], const Unit& u, int wr, int wc, int fr, int fq) const {
        const int row0 = u.pm * BM + wr * 64 + fr; const int col0 = u.pn * BM + wc * 32 + 8 * fq; const float sc = scale;
#pragma unroll
        for (int ai = 0; ai < 2; ++ai)
#pragma unroll
            for (int m = 0; m < 4; ++m) { bf16_t* rowp = O + (size_t)(row0 + ai * HALF + m * 16) * ldc + col0;
#pragma unroll
                for (int bj = 0; bj < 2; ++bj) { f32x4 v0 = acc[ai][bj][m][0] * sc, v1 = acc[ai][bj][m][1] * sc;
                    u32x4 w; w.x = cvt_pk_bf16(v0[0], v0[1]); w.y = cvt_pk_bf16(v0[2], v0[3]); w.z = cvt_pk_bf16(v1[0], v1[1]); w.w = cvt_pk_bf16(v1[2], v1[3]);
                    *(u32x4*)(rowp + bj * HALF) = w; } asm volatile("" ::: "memory"); }
    }
};
__device__ __forceinline__ float silu_f(float x) { return x * __builtin_amdgcn_rcpf(1.0f + __builtin_amdgcn_exp2f(-1.4426950408889634f * x)); }
struct EpiSwiGLU {
    static constexpr bool PERM = true, AFTER_DRAIN = false;
    bf16_t* O; int ldc;
    __device__ __forceinline__ void operator()(const f32x4 (&acc)[2][2][4][2], const Unit& u, int wr, int wc, int fr, int fq) const {
        const int row0 = u.pm * BM + wr * 64 + fr; const int col0 = u.pn * HALF + wc * 32 + 8 * fq;
#pragma unroll
        for (int ai = 0; ai < 2; ++ai)
#pragma unroll
            for (int m = 0; m < 4; ++m) { bf16_t* rowp = O + (size_t)(row0 + ai * HALF + m * 16) * ldc + col0;
                const f32x4 g0 = acc[ai][0][m][0], g1 = acc[ai][0][m][1], u0 = acc[ai][1][m][0], u1 = acc[ai][1][m][1];
                float h[8];
#pragma unroll
                for (int e = 0; e < 4; ++e) { h[e] = silu_f(g0[e]) * u0[e]; h[4 + e] = silu_f(g1[e]) * u1[e]; }
                u32x4 w; w.x = cvt_pk_bf16(h[0], h[1]); w.y = cvt_pk_bf16(h[2], h[3]); w.z = cvt_pk_bf16(h[4], h[5]); w.w = cvt_pk_bf16(h[6], h[7]);
                *(u32x4*)rowp = w; asm volatile("" ::: "memory"); }
    }
};
struct EpiProj {
    static constexpr bool PERM = true, AFTER_DRAIN = false;
    bf16_t* PJ; float* SM; float qscale;
    __device__ __forceinline__ void operator()(const f32x4 (&acc)[2][2][4][2], const Unit& u, int wr, int wc, int fr, int fq) const {
        const int row0 = u.pm * BM + wr * 64 + fr;
        if (u.pn < 12) {
            const int col0 = u.pn * BM + wc * 32 + 8 * fq; const float sc = (u.pn < 2) ? qscale : 1.0f;
#pragma unroll
            for (int ai = 0; ai < 2; ++ai)
#pragma unroll
                for (int m = 0; m < 4; ++m) { bf16_t* rowp = PJ + (size_t)(row0 + ai * HALF + m * 16) * 3072 + col0;
#pragma unroll
                    for (int bj = 0; bj < 2; ++bj) { f32x4 v0 = acc[ai][bj][m][0] * sc, v1 = acc[ai][bj][m][1] * sc;
                        u32x4 w; w.x = cvt_pk_bf16(v0[0], v0[1]); w.y = cvt_pk_bf16(v0[2], v0[3]); w.z = cvt_pk_bf16(v1[0], v1[1]); w.w = cvt_pk_bf16(v1[2], v1[3]);
                        *(u32x4*)(rowp + bj * HALF) = w; } asm volatile("" ::: "memory"); }
        } else if (wc == 0 && fq < 2) {
#pragma unroll
            for (int ai = 0; ai < 2; ++ai)
#pragma unroll
                for (int m = 0; m < 4; ++m) { float* rowp = SM + (size_t)(row0 + ai * HALF + m * 16) * 16 + 8 * fq;
                    *(f32x4*)rowp = acc[ai][0][m][0]; *(f32x4*)(rowp + 4) = acc[ai][0][m][1]; }
        }
    }
};
template <int LDC> struct EpiBf16Map {
    static constexpr bool PERM = true, AFTER_DRAIN = false;
    bf16_t* O; int sh; size_t lo_off, hi_off, pn_off; float scale;
    __device__ __forceinline__ void operator()(const f32x4 (&acc)[2][2][4][2], const Unit& u, int wr, int wc, int fr, int fq) const {
        bf16_t* base = O + (size_t)(u.pm & ((1 << sh) - 1)) * lo_off + (size_t)(u.pm >> sh) * hi_off + (size_t)u.pn * pn_off + (size_t)(wr * 64 + fr) * LDC + (wc * 32 + 8 * fq); const float sc = scale;
#pragma unroll
        for (int ai = 0; ai < 2; ++ai)
#pragma unroll
            for (int m = 0; m < 4; ++m) { bf16_t* rowp = base + (ai * HALF + m * 16) * LDC;
#pragma unroll
                for (int bj = 0; bj < 2; ++bj) { f32x4 v0 = acc[ai][bj][m][0] * sc, v1 = acc[ai][bj][m][1] * sc;
                    u32x4 w; w.x = cvt_pk_bf16(v0[0], v0[1]); w.y = cvt_pk_bf16(v0[2], v0[3]); w.z = cvt_pk_bf16(v1[0], v1[1]); w.w = cvt_pk_bf16(v1[2], v1[3]);
                    *(u32x4*)(rowp + bj * HALF) = w; } asm volatile("" ::: "memory"); }
    }
};
struct EpiSoftmax {
    static constexpr bool PERM = true, AFTER_DRAIN = false;
    bf16_t* O; int ldc; PG8_LAS unsigned char* xl;
    __device__ __forceinline__ void operator()(const f32x4 (&acc_in)[2][2][4][2], const Unit& u, int wr, int wc, int fr, int fq) const {
        f32x4 (&acc)[2][2][4][2] = const_cast<f32x4 (&)[2][2][4][2]>(acc_in);
        PG8_LAS f32x4* PM = (PG8_LAS f32x4*)xl; PG8_LAS f32x4* PS = (PG8_LAS f32x4*)(xl + 4096);
        PG8_LAS float* PMf = (PG8_LAS float*)xl; PG8_LAS float* PSf = (PG8_LAS float*)(xl + 4096);
#pragma unroll
        for (int ai = 0; ai < 2; ++ai)
#pragma unroll
            for (int m = 0; m < 4; ++m) { float mx = -INFINITY;
#pragma unroll
                for (int bj = 0; bj < 2; ++bj)
#pragma unroll
                    for (int n = 0; n < 2; ++n) { const f32x4 x = acc[ai][bj][m][n]; mx = fmaxf(mx, fmaxf(fmaxf(x[0], x[1]), fmaxf(x[2], x[3]))); }
                mx = fmaxf(mx, __shfl_xor(mx, 16)); mx = fmaxf(mx, __shfl_xor(mx, 32));
                if (fq == 0) PMf[(ai * HALF + wr * 64 + m * 16 + fr) * 4 + wc] = mx; }
        asm volatile("s_waitcnt lgkmcnt(0)" ::: "memory"); __builtin_amdgcn_s_barrier(); asm volatile("" ::: "memory");
#pragma unroll
        for (int ai = 0; ai < 2; ++ai)
#pragma unroll
            for (int m = 0; m < 4; ++m) { const int r = ai * HALF + wr * 64 + m * 16 + fr; const f32x4 p = PM[r]; const float rm = fmaxf(fmaxf(p[0], p[1]), fmaxf(p[2], p[3])); float sm = 0.f;
#pragma unroll
                for (int bj = 0; bj < 2; ++bj)
#pragma unroll
                    for (int n = 0; n < 2; ++n) { const f32x4 x = acc[ai][bj][m][n];
                        const float e0 = __builtin_amdgcn_exp2f(x[0] - rm), e1 = __builtin_amdgcn_exp2f(x[1] - rm), e2 = __builtin_amdgcn_exp2f(x[2] - rm), e3 = __builtin_amdgcn_exp2f(x[3] - rm);
                        sm += (e0 + e1) + (e2 + e3); acc[ai][bj][m][n] = (f32x4){e0, e1, e2, e3}; }
                sm += __shfl_xor(sm, 16); sm += __shfl_xor(sm, 32);
                if (fq == 0) PSf[r * 4 + wc] = sm; }
        asm volatile("s_waitcnt lgkmcnt(0)" ::: "memory"); __builtin_amdgcn_s_barrier(); asm volatile("" ::: "memory");
        const int row0 = u.pm * BM + wr * 64 + fr; const int col0 = u.pn * BM + wc * 32 + 8 * fq;
#pragma unroll
        for (int ai = 0; ai < 2; ++ai)
#pragma unroll
            for (int m = 0; m < 4; ++m) { const int r = ai * HALF + wr * 64 + m * 16 + fr; const f32x4 p = PS[r]; const float inv = 1.0f / ((p[0] + p[1]) + (p[2] + p[3]));
                bf16_t* rowp = O + (size_t)(row0 + ai * HALF + m * 16) * ldc + col0;
#pragma unroll
                for (int bj = 0; bj < 2; ++bj) { const f32x4 v0 = acc[ai][bj][m][0] * inv, v1 = acc[ai][bj][m][1] * inv;
                    u32x4 w; w.x = cvt_pk_bf16(v0[0], v0[1]); w.y = cvt_pk_bf16(v0[2], v0[3]); w.z = cvt_pk_bf16(v1[0], v1[1]); w.w = cvt_pk_bf16(v1[2], v1[3]);
                    *(u32x4*)(rowp + bj * HALF) = w; } asm volatile("" ::: "memory"); }
    }
};
template <class Epi, class Sched, bool ALIGN_EPI = false, bool SP2 = false>
__device__ __forceinline__ void gemm_phase(PG8_LAS unsigned char* lds, const Gemm g, const Sched& S, const Epi& E) {
    int tid_l = threadIdx.x; asm volatile("" : "+v"(tid_l));
    const int tid = tid_l, wid = __builtin_amdgcn_readfirstlane(tid >> 6), lane = tid & 63, wr = wid >> 2, wc = wid & 3, fr = lane & 15, fq = lane >> 4;
    const int K = g.K, nt = K / BK;
    unsigned voffA[2], voffB[2];
#pragma unroll
    for (int i = 0; i < 2; ++i) { int R, C; stage_rc(tid * 16 + i * 8192, R, C); const int Rb = Epi::PERM ? ((R & ~31) + perm32(R & 31)) : R;
        voffA[i] = (unsigned)(R * K + C) * 2u; voffB[i] = (unsigned)(Rb * K + C) * 2u; }
    const size_t kstep = (size_t)(BK * 2);
    const size_t hstep = (size_t)HALF * K * 2;
    const size_t tstep = 2 * hstep;
    const unsigned ldsw = (unsigned)wid * 1024u;
    const int aoff = lds_byte(wr * 64 + fr, fq * 8), boff = lds_byte(wc * 32 + fr, fq * 8);
#define PG8_SA(b, h) (((b) * 2 + (h)) * HTB)
#define PG8_SB(b, h) ((4 + (b) * 2 + (h)) * HTB)
#define PG8_STAGE(bufoff, gbase, voff) do { _Pragma("unroll") for (int _i = 0; _i < 2; ++_i) \
        __builtin_amdgcn_global_load_lds((const unsigned*)((const char*)(gbase) + (voff)[_i]), (PG8_LAS unsigned*)(lds + (bufoff) + ldsw + _i * 8192), 16, 0, 0); } while (0)
#define PG8_LDA(dst, b, h) do { _Pragma("unroll") for (int m = 0; m < 4; ++m) _Pragma("unroll") for (int k = 0; k < 2; ++k) dst[m][k] = *(const PG8_LAS bf16x8*)(lds + PG8_SA(b, h) + aoff + m * 2048 + k * 1024); } while (0)
#define PG8_LDB(dst, b, h) do { _Pragma("unroll") for (int n = 0; n < 2; ++n) _Pragma("unroll") for (int k = 0; k < 2; ++k) dst[n][k] = *(const PG8_LAS bf16x8*)(lds + PG8_SB(b, h) + boff + n * 2048 + k * 1024); } while (0)
#define PG8_MMA(ai, bj, At, Bt) do { __builtin_amdgcn_s_setprio(1); _Pragma("unroll") for (int m = 0; m < 4; ++m) _Pragma("unroll") for (int n = 0; n < 2; ++n) _Pragma("unroll") for (int k = 0; k < 2; ++k) \
        acc[ai][bj][m][n] = __builtin_amdgcn_mfma_f32_16x16x32_bf16(Bt[n][k], At[m][k], acc[ai][bj][m][n], 0, 0, 0); __builtin_amdgcn_s_setprio(0); } while (0)
#define PG8_WAIT_V(n) asm volatile("s_waitcnt vmcnt(" #n ")" ::: "memory")
#define PG8_WAIT_L(n) asm volatile("s_waitcnt lgkmcnt(" #n ")" ::: "memory")
#define PG8_BAR __builtin_amdgcn_s_barrier()
#define PG8_SCHED __builtin_amdgcn_sched_barrier(0)
    Unit cur, nxt; int ui = 0;
    if (!S.next(0, cur)) return;
    f32x4 acc[2][2][4][2];
#pragma unroll
    for (int a = 0; a < 2; ++a)
#pragma unroll
        for (int b = 0; b < 2; ++b)
#pragma unroll
            for (int m = 0; m < 4; ++m)
#pragma unroll
                for (int n = 0; n < 2; ++n) acc[a][b][m][n] = (f32x4){0.f, 0.f, 0.f, 0.f};
    bf16x8 At[4][2], B0[2][2], B1[2][2];
    const char* cA = (const char*)g.A + (size_t)cur.pm * tstep; const char* cB = (const char*)g.Bt + (size_t)cur.pn * tstep + (size_t)(cur.pm >> g.bsh) * g.bbs;
    S.a_ready(cur);
    if constexpr (SP2) {
        PG8_STAGE(PG8_SB(0, 0), cB, voffB); PG8_STAGE(PG8_SB(0, 1), cB + hstep, voffB); PG8_STAGE(PG8_SA(0, 0), cA, voffA); PG8_STAGE(PG8_SA(0, 1), cA + hstep, voffA);
        if (wr == 1) PG8_BAR;
        PG8_WAIT_V(2); PG8_BAR;
        PG8_STAGE(PG8_SB(1, 0), cB + kstep, voffB); PG8_STAGE(PG8_SA(1, 0), cA + kstep, voffA); PG8_STAGE(PG8_SB(1, 1), cB + hstep + kstep, voffB);
        PG8_WAIT_V(6); PG8_BAR;
    } else {
        PG8_STAGE(PG8_SB(0, 0), cB, voffB); PG8_STAGE(PG8_SA(0, 0), cA, voffA); PG8_STAGE(PG8_SB(0, 1), cB + hstep, voffB); PG8_STAGE(PG8_SA(0, 1), cA + hstep, voffA);
        if (wr == 1) PG8_BAR;
        PG8_WAIT_V(4); PG8_BAR;
        PG8_STAGE(PG8_SB(1, 0), cB + kstep, voffB); PG8_STAGE(PG8_SA(1, 0), cA + kstep, voffA); PG8_STAGE(PG8_SB(1, 1), cB + hstep + kstep, voffB);
        PG8_WAIT_V(6); PG8_BAR;
    }
    for (;;) {
        const bool has_next = S.next(ui + 1, nxt);
        const char* nA = has_next ? (const char*)g.A + (size_t)nxt.pm * tstep : cA; const char* nB = has_next ? (const char*)g.Bt + (size_t)nxt.pn * tstep + (size_t)(nxt.pm >> g.bsh) * g.bbs : cB;
        for (int t = 0; t < nt; t += 2) {
            const bool last = (t == nt - 2);
            const char* a1 = cA + (size_t)(t + 1) * kstep;
            const char* a2 = last ? nA : cA + (size_t)(t + 2) * kstep; const char* b2 = last ? nB : cB + (size_t)(t + 2) * kstep;
            const char* a3 = a2 + kstep; const char* b3 = b2 + kstep;
            if (last && has_next) S.a_ready(nxt);
            if constexpr (SP2) {
            PG8_LDB(B0, 0, 0); PG8_LDB(B1, 0, 1); PG8_SCHED; PG8_LDA(At, 0, 0); PG8_STAGE(PG8_SA(1, 1), a1 + hstep, voffA);
            PG8_WAIT_V(8); PG8_WAIT_L(0); PG8_BAR; PG8_MMA(0, 0, At, B0); PG8_MMA(0, 1, At, B1); PG8_BAR; PG8_SCHED;
            PG8_LDA(At, 0, 1); PG8_STAGE(PG8_SB(0, 0), b2, voffB); PG8_STAGE(PG8_SB(0, 1), b2 + hstep, voffB); PG8_STAGE(PG8_SA(0, 0), a2, voffA);
            PG8_WAIT_V(8); PG8_WAIT_L(0); PG8_BAR; PG8_MMA(1, 0, At, B0); PG8_MMA(1, 1, At, B1); PG8_BAR; PG8_SCHED;
            PG8_LDB(B0, 1, 0); PG8_LDB(B1, 1, 1); PG8_SCHED; PG8_LDA(At, 1, 0); PG8_STAGE(PG8_SA(0, 1), a2 + hstep, voffA);
            PG8_WAIT_V(8); PG8_WAIT_L(0); PG8_BAR; PG8_MMA(0, 0, At, B0); PG8_MMA(0, 1, At, B1); PG8_BAR; PG8_SCHED;
            PG8_LDA(At, 1, 1); PG8_STAGE(PG8_SB(1, 0), b3, voffB); PG8_STAGE(PG8_SB(1, 1), b3 + hstep, voffB); PG8_STAGE(PG8_SA(1, 0), a3, voffA);
            PG8_WAIT_V(8); PG8_WAIT_L(0); PG8_BAR; PG8_MMA(1, 0, At, B0); PG8_MMA(1, 1, At, B1); PG8_BAR; PG8_SCHED;
            } else {
            PG8_LDB(B0, 0, 0); PG8_SCHED; PG8_LDA(At, 0, 0); PG8_STAGE(PG8_SA(1, 1), a1 + hstep, voffA);
            PG8_WAIT_L(8); PG8_BAR; PG8_WAIT_L(0); PG8_MMA(0, 0, At, B0); PG8_BAR; PG8_SCHED;
            PG8_LDB(B1, 0, 1); PG8_STAGE(PG8_SB(0, 0), b2, voffB);
            PG8_BAR; PG8_WAIT_L(0); PG8_MMA(0, 1, At, B1); PG8_BAR;
            PG8_LDA(At, 0, 1); PG8_STAGE(PG8_SA(0, 0), a2, voffA);
            PG8_BAR; PG8_WAIT_L(0); PG8_MMA(1, 0, At, B0); PG8_BAR; PG8_SCHED;
            PG8_STAGE(PG8_SB(0, 1), b2 + hstep, voffB);
            PG8_WAIT_V(6); PG8_BAR; PG8_MMA(1, 1, At, B1); PG8_BAR;
            PG8_LDB(B0, 1, 0); PG8_SCHED; PG8_LDA(At, 1, 0); PG8_STAGE(PG8_SA(0, 1), a2 + hstep, voffA);
            PG8_WAIT_L(8); PG8_BAR; PG8_WAIT_L(0); PG8_MMA(0, 0, At, B0); PG8_BAR; PG8_SCHED;
            PG8_LDB(B1, 1, 1); PG8_STAGE(PG8_SB(1, 0), b3, voffB);
            PG8_BAR; PG8_WAIT_L(0); PG8_MMA(0, 1, At, B1); PG8_BAR;
            PG8_LDA(At, 1, 1); PG8_STAGE(PG8_SA(1, 0), a3, voffA);
            PG8_BAR; PG8_WAIT_L(0); PG8_MMA(1, 0, At, B0); PG8_BAR; PG8_SCHED;
            PG8_STAGE(PG8_SB(1, 1), b3 + hstep, voffB);
            PG8_WAIT_V(6); PG8_BAR; PG8_MMA(1, 1, At, B1); PG8_BAR;
            }
        }
        if constexpr (ALIGN_EPI) { if (wr == 0) PG8_BAR; }
        if constexpr (!Epi::AFTER_DRAIN) { E(acc, cur, wr, wc, fr, fq); S.done(cur); }
        if (!has_next) break;
#pragma unroll
        for (int a = 0; a < 2; ++a)
#pragma unroll
            for (int b = 0; b < 2; ++b)
#pragma unroll
                for (int m = 0; m < 4; ++m)
#pragma unroll
                    for (int n = 0; n < 2; ++n) acc[a][b][m][n] = (f32x4){0.f, 0.f, 0.f, 0.f};
        cur = nxt; cA = nA; cB = nB; ++ui;
        if constexpr (ALIGN_EPI) { if (wr == 1) PG8_BAR; }
    }
    PG8_WAIT_V(0);
    if constexpr (!ALIGN_EPI) { if (wr == 0) PG8_BAR; }
    PG8_BAR;
    if constexpr (Epi::AFTER_DRAIN) { E.fused(acc, cur, wr, wc, fr, fq, lds, wid, lane); S.done(cur); }
#undef PG8_SA
#undef PG8_SB
#undef PG8_STAGE
#undef PG8_LDA
#undef PG8_LDB
#undef PG8_MMA
#undef PG8_WAIT_V
#undef PG8_WAIT_L
#undef PG8_BAR
#undef PG8_SCHED
}
}
#define LAS __attribute__((address_space(3)))
typedef unsigned short bf16_t;
typedef short bf16x8 __attribute__((ext_vector_type(8)));
typedef float f32x4 __attribute__((ext_vector_type(4)));
typedef unsigned u32x4 __attribute__((ext_vector_type(4)));
typedef unsigned u32x2 __attribute__((ext_vector_type(2)));
using pg8::cvt_pk_bf16;
constexpr int SEQ = 8192, NB = 8, MTOK = NB * SEQ, DM = 1024, DFF = 2816, NMEM = 256;
constexpr float EPSN = 1e-6f, LOG2E = 1.4426950408889634f;
constexpr float FOX_QSCALE = 0.125f * LOG2E;
constexpr float MEM_QSCALE = 0.0625f * LOG2E;
constexpr float FOX_T2 = 40.0f;
constexpr size_t MiB = 1u << 20;
constexpr size_t WS_CTL = 0, CTL_BYTES = 32768, WS_XBAR = 65536;
constexpr size_t WS_SM = 2 * MiB, WS_FC = 6 * MiB, WS_KMEM = 8 * MiB, WS_VMEMT = 12 * MiB, WS_AMEM = 16 * MiB, WS_MISC = 20 * MiB;
constexpr size_t WS_WGU1 = 24 * MiB, WS_WD1 = 35 * MiB, WS_WIN = 41 * MiB, WS_WVT = 48 * MiB, WS_WOUT = 49 * MiB, WS_WQ = 51 * MiB, WS_WKV = 53 * MiB, WS_WO = 57 * MiB, WS_WGU2 = 59 * MiB, WS_WD2 = 70 * MiB;
constexpr size_t WS_A = 80 * MiB, WS_F = 208 * MiB, WS_BIG = 336 * MiB, WS_VT = 720 * MiB, WS_UT = 784 * MiB, WS_KTT = 848 * MiB, WS_ATT = 912 * MiB, WS_END = 1008 * MiB;
constexpr size_t WS_NW = WS_F, WS_QD = WS_F + 64 * MiB;
constexpr size_t WS_ORAW = 944 * MiB;
constexpr size_t WS_WQH = 76 * MiB, WS_WOTH = 78 * MiB;
constexpr size_t WS_MB = 848 * MiB, WS_NB = 864 * MiB;
constexpr size_t WS_HB = WS_VT;
constexpr size_t WS_XS = 944 * MiB, XS_BYTES = (size_t)65536 * 16 * 4, WS_XCNT = 262144;
constexpr size_t MISC_KT0 = 0, MISC_EGL = 65536;
constexpr int LDS_BYTES = 153600;
constexpr int LDS_BCAST = 152000;

struct Params { const float* in[27]; float* out; unsigned char* ws; };

__device__ __forceinline__ float bf2f(unsigned short b) { return __uint_as_float((unsigned)b << 16); }
__device__ __forceinline__ float bflo(unsigned w) { return __uint_as_float(w << 16); }
__device__ __forceinline__ float bfhi(unsigned w) { return __uint_as_float(w & 0xffff0000u); }
__device__ __forceinline__ float wave_sum(float v) {
#pragma unroll
    for (int o = 1; o < 64; o <<= 1) v += __shfl_xor(v, o);
    return v;
}
__device__ __forceinline__ float softplus_f(float x) { return fmaxf(x, 0.f) + log1pf(__expf(-fabsf(x))); }
#define LDS_WAIT() asm volatile("s_waitcnt lgkmcnt(0)" ::: "memory")

#define XB_TMO      128
#define XB_XCNT(j)  (256  + 64 * (j))
#define XB_XSUB(j)  (1280 + 64 * (j))
#define XB_XGEN(j)  (2304 + 64 * (j))
#define XB_TOP      3328
#define XB_TOPGEN   3392
#define XCD_BAR_WORDS 3456
#define XB_SPIN_CAP (1u << 18)

__device__ __forceinline__ unsigned xb_ld(unsigned* p)              { return __hip_atomic_load(p, __ATOMIC_RELAXED, __HIP_MEMORY_SCOPE_AGENT); }
__device__ __forceinline__ unsigned xb_add(unsigned* p, unsigned v) { return __hip_atomic_fetch_add(p, v, __ATOMIC_RELAXED, __HIP_MEMORY_SCOPE_AGENT); }
__device__ __forceinline__ unsigned xb_xcc_id() { return (unsigned)__builtin_amdgcn_s_getreg((3 << 11) | 20) & 0xFu; }
#define XB_SPIN(cond, bar) do { unsigned _sp = 0; while (cond) { __builtin_amdgcn_s_sleep(1); \
    if ((++_sp & 255u) == 0u) { if (xb_ld(&(bar)[XB_TMO])) break; if (_sp > XB_SPIN_CAP) { atomicAdd(&(bar)[XB_TMO], 1u); break; } } } } while (0)

struct XcdBarrier {
    unsigned* bar; unsigned x;
    volatile LAS unsigned* st;
};

__device__ __forceinline__ XcdBarrier xcd_barrier_post(unsigned* bar, volatile LAS unsigned* st) {
    XcdBarrier b; b.bar = bar; b.x = xb_xcc_id(); b.st = st;
    if (threadIdx.x == 0) (void)xb_add(&bar[XB_XCNT(b.x)], 1u);
    return b;
}
__device__ __forceinline__ void xcd_barrier_complete(unsigned* bar, unsigned x, unsigned& nloc, unsigned& nx) {
    const unsigned G = gridDim.x * gridDim.y * gridDim.z;
    unsigned sum, cnt, mine, sp = 0u;
    for (;;) {
        sum = 0u; cnt = 0u; mine = 0u;
#pragma unroll
        for (unsigned j = 0; j < 16; ++j) { const unsigned c = xb_ld(&bar[XB_XCNT(j)]); sum += c; cnt += (c > 0u) ? 1u : 0u; mine = (j == x) ? c : mine; }
        if (sum == G) break;
        __builtin_amdgcn_s_sleep(1);
        if ((++sp & 255u) == 0u) { if (xb_ld(&bar[XB_TMO])) break; if (sp > XB_SPIN_CAP) { atomicAdd(&bar[XB_TMO], 1u); break; } }
    }
    nloc = mine > 0u ? mine : 1u; nx = cnt > 0u ? cnt : 1u;
}

__device__ __forceinline__ void xcd_barrier(const XcdBarrier& b) {
    asm volatile("s_waitcnt vmcnt(0)" ::: "memory");
    __syncthreads();
    if (threadIdx.x == 0) {
        unsigned* bar = b.bar;
        __builtin_amdgcn_s_waitcnt(0);
        unsigned nloc = b.st[0], nx = b.st[1];
        if (nloc == 0u) { xcd_barrier_complete(bar, b.x, nloc, nx); b.st[0] = nloc; b.st[1] = nx; }
        const unsigned old = xb_add(&bar[XB_XSUB(b.x)], 1u);
        const unsigned gen = old / nloc;
        if (old + 1u == (gen + 1u) * nloc) {
            __builtin_amdgcn_fence(__ATOMIC_RELEASE, "agent");
            asm volatile("s_waitcnt vmcnt(0)" ::: "memory");
            const unsigned og = xb_add(&bar[XB_TOP], 1u);
            const unsigned tg = og / nx;
            if (og + 1u == (tg + 1u) * nx) xb_add(&bar[XB_TOPGEN], 1u);
            else XB_SPIN(xb_ld(&bar[XB_TOPGEN]) == tg, bar);
            __builtin_amdgcn_fence(__ATOMIC_ACQUIRE, "agent");
            xb_add(&bar[XB_XGEN(b.x)], 1u);
            asm volatile("s_waitcnt vmcnt(0)" ::: "memory");
        } else {
            XB_SPIN(xb_ld(&bar[XB_XGEN(b.x)]) == gen, bar);
            __builtin_amdgcn_fence(__ATOMIC_ACQUIRE, "agent");
            asm volatile("s_waitcnt vmcnt(0)" ::: "memory");
        }
    }
    __syncthreads();
}


struct MapIdent { int off; __device__ __forceinline__ int operator()(int n) const { return n + off; } };
struct MapGate { __device__ __forceinline__ int operator()(int n) const { return (n >> 7) * 256 + (n & 127); } };
struct MapUp { __device__ __forceinline__ int operator()(int n) const { return (n >> 7) * 256 + 128 + (n & 127); } };
struct MapWin { __device__ __forceinline__ int operator()(int n) const {
    if (n < 1024) return n; if (n < 1536) return -1; if (n < 1544) return 3072 + (n - 1536); if (n < 3592) return 1024 + (n - 1544); return 3080 + (n - 3592); } };
struct MapWinV { __device__ __forceinline__ int operator()(int n) const { return (n >= 1024 && n < 1536) ? n - 1024 : -1; } };

template <class Map> __device__ __forceinline__ void transpose_item(const float* W, int K, int N, bf16_t* WT, const Map map, LAS float* scr, int item, int lane) {
    const int nblk = (N + 31) >> 5, kb = item / nblk, nb = item - kb * nblk, k0 = 64 * kb, n0 = 32 * nb;
    const int r8 = lane >> 3, c4 = (lane & 7) * 4, nn = n0 + c4;
    f32x4 tv[8];
#pragma unroll
    for (int i = 0; i < 8; ++i) tv[i] = (nn < N) ? *(const f32x4*)(W + (size_t)(k0 + 8 * i + r8) * N + nn) : (f32x4){0.f, 0.f, 0.f, 0.f};
#pragma unroll
    for (int i = 0; i < 8; ++i) { LAS float* d = scr + (8 * i + r8) * 33 + c4; d[0] = tv[i].x; d[1] = tv[i].y; d[2] = tv[i].z; d[3] = tv[i].w; }
    LDS_WAIT(); asm volatile("" ::: "memory");
    const int c = lane & 7;
#pragma unroll
    for (int j = 0; j < 4; ++j) { const int nl = (lane >> 3) + 8 * j; const int n = n0 + nl; const LAS float* s = scr + (8 * c) * 33 + nl;
        if (n < N) { const int dr = map(n);
            if (dr >= 0) { u32x4 o; o.x = cvt_pk_bf16(s[0 * 33], s[1 * 33]); o.y = cvt_pk_bf16(s[2 * 33], s[3 * 33]); o.z = cvt_pk_bf16(s[4 * 33], s[5 * 33]); o.w = cvt_pk_bf16(s[6 * 33], s[7 * 33]);
                *(u32x4*)(WT + (size_t)dr * K + k0 + 8 * c) = o; } } }
    LDS_WAIT(); asm volatile("" ::: "memory");
}
template <class Map> __device__ __forceinline__ void transpose_all(const float* W, int K, int N, bf16_t* WT, const Map map, LAS float* scr, int gw, int ngw, int lane) {
    const int nitems = (K / 64) * ((N + 31) >> 5);
    for (int it = gw; it < nitems; it += ngw) transpose_item(W, K, N, WT, map, scr, it, lane);
}

__device__ __forceinline__ void row_phase(const float* hin, const bf16_t* hin_b, const bf16_t* Fb, const float* gpost, float wres, float* hout, bf16_t* hout_b, const float* gnext, bf16_t* Aout, int nrows, int gw, int ngw, int lane) {
    f32x4 gp[4], gn[4];
#pragma unroll
    for (int j = 0; j < 4; ++j) { gp[j] = Fb ? ((const f32x4*)gpost)[lane + 64 * j] : (f32x4){0.f, 0.f, 0.f, 0.f}; gn[j] = Aout ? ((const f32x4*)gnext)[lane + 64 * j] : (f32x4){0.f, 0.f, 0.f, 0.f}; }
    for (int r0 = gw; r0 < nrows; r0 += 2 * ngw) {
        const bool two = (r0 + ngw) < nrows;
        f32x4 v[2][4]; u32x2 fw[2][4];
#pragma unroll
        for (int q = 0; q < 2; ++q) { const int r = r0 + q * ngw;
            if (q == 0 || two) {
#pragma unroll
                for (int j = 0; j < 4; ++j) {
                    if (hin_b) { const u32x2 w = ((const u32x2*)(hin_b + (size_t)r * DM))[lane + 64 * j]; v[q][j] = (f32x4){bflo(w.x), bfhi(w.x), bflo(w.y), bfhi(w.y)}; }
                    else v[q][j] = ((const f32x4*)(hin + (size_t)r * DM))[lane + 64 * j];
                    if (Fb) fw[q][j] = ((const u32x2*)(Fb + (size_t)r * DM))[lane + 64 * j]; } } }
#pragma unroll
        for (int q = 0; q < 2; ++q) { const int r = r0 + q * ngw;
            if (q == 0 || two) {
                if (Fb) {
                    f32x4 f[4]; float ss = 0.f;
#pragma unroll
                    for (int j = 0; j < 4; ++j) { const u32x2 w = fw[q][j];
                        f[j] = (f32x4){bflo(w.x), bfhi(w.x), bflo(w.y), bfhi(w.y)}; ss += (f[j].x * f[j].x + f[j].y * f[j].y) + (f[j].z * f[j].z + f[j].w * f[j].w); }
                    const float rs = wres * rsqrtf(wave_sum(ss) * (1.f / DM) + EPSN);
#pragma unroll
                    for (int j = 0; j < 4; ++j) v[q][j] = v[q][j] + (f[j] * rs) * gp[j];
                }
                if (hout) {
#pragma unroll
                    for (int j = 0; j < 4; ++j) ((f32x4*)(hout + (size_t)r * DM))[lane + 64 * j] = v[q][j];
                }
                if (hout_b) {
#pragma unroll
                    for (int j = 0; j < 4; ++j) { u32x2 w; w.x = cvt_pk_bf16(v[q][j].x, v[q][j].y); w.y = cvt_pk_bf16(v[q][j].z, v[q][j].w); ((u32x2*)(hout_b + (size_t)r * DM))[lane + 64 * j] = w; }
                }
                if (Aout) {
                    float ss = 0.f;
#pragma unroll
                    for (int j = 0; j < 4; ++j) ss += (v[q][j].x * v[q][j].x + v[q][j].y * v[q][j].y) + (v[q][j].z * v[q][j].z + v[q][j].w * v[q][j].w);
                    const float rs = rsqrtf(wave_sum(ss) * (1.f / DM) + EPSN);
#pragma unroll
                    for (int j = 0; j < 4; ++j) { const f32x4 o = (v[q][j] * rs) * gn[j]; u32x2 w; w.x = cvt_pk_bf16(o.x, o.y); w.y = cvt_pk_bf16(o.z, o.w);
                        ((u32x2*)(Aout + (size_t)r * DM))[lane + 64 * j] = w; }
                }
            } }
    }
}

template <int D, bool FOX, int QG>
__device__ __forceinline__ void attn_unit(LAS unsigned char* lds, const bf16_t* Q, int ldq, const bf16_t* K, int ldk, const bf16_t* VT, int ldvt, bf16_t* O, int ldo,
                                          const float* Fc, int qb, int kt0, int kt1, int tid, int wid, int lane) {
    constexpr int KP = D + 8, VP = 72, NP = D / 64, KS = D / 32, DJ = D / 16;
    LAS bf16_t* Kl = (LAS bf16_t*)lds; LAS bf16_t* Vl = (LAS bf16_t*)(lds + 64 * KP * 2); LAS float* Fk = (LAS float*)(lds + 64 * KP * 2 + D * VP * 2);
    const int fr = lane & 15, fq = lane >> 4;
    const int q0 = qb * (128 * QG) + wid * (16 * QG);
    bf16x8 qf[QG][KS]; float Fq[QG]; f32x4 o[QG][DJ]; float mrun[QG], lrun[QG];
#pragma unroll
    for (int g = 0; g < QG; ++g) {
#pragma unroll
        for (int ks = 0; ks < KS; ++ks) qf[g][ks] = *(const bf16x8*)(Q + (size_t)(q0 + 16 * g + fr) * ldq + 32 * ks + 8 * fq);
        Fq[g] = 0.f; if (FOX) Fq[g] = Fc[q0 + 16 * g + fr];
#pragma unroll
        for (int dj = 0; dj < DJ; ++dj) o[g][dj] = (f32x4){0.f, 0.f, 0.f, 0.f};
        mrun[g] = -INFINITY; lrun[g] = 0.f; }
    u32x4 kreg[NP], vreg[NP]; float fkreg = 0.f;
#define ATT_GLOAD(kt) do { _Pragma("unroll") for (int i_ = 0; i_ < NP; ++i_) { const int p_ = tid + 512 * i_; \
        { const int row_ = p_ / (D / 8), c_ = p_ % (D / 8); kreg[i_] = *(const u32x4*)(K + (size_t)((kt) * 64 + row_) * ldk + c_ * 8); } \
        { const int row_ = p_ >> 3, c_ = p_ & 7; vreg[i_] = *(const u32x4*)(VT + (size_t)row_ * ldvt + (kt) * 64 + c_ * 8); } } \
        if (FOX && tid < 64) fkreg = Fc[(kt) * 64 + tid]; } while (0)
    ATT_GLOAD(kt0);
    for (int kt = kt0; kt <= kt1; ++kt) {
        __syncthreads();
#pragma unroll
        for (int i = 0; i < NP; ++i) { const int p = tid + 512 * i;
            { const int row = p / (D / 8), c = p % (D / 8); *(LAS u32x4*)(Kl + row * KP + c * 8) = kreg[i]; }
            { const int row = p >> 3, c = p & 7; *(LAS u32x4*)(Vl + row * VP + c * 8) = vreg[i]; } }
        if (FOX && tid < 64) Fk[tid] = fkreg;
        __syncthreads();
        if (kt < kt1) ATT_GLOAD(kt + 1);
        if (FOX && kt * 64 > q0 + 16 * QG - 1) continue;
        f32x4 s[QG][4];
#pragma unroll
        for (int g = 0; g < QG; ++g)
#pragma unroll
            for (int j = 0; j < 4; ++j) { if (FOX) { const f32x4 fk4 = *(const LAS f32x4*)(Fk + 16 * j + 4 * fq); s[g][j] = Fq[g] - fk4; } else s[g][j] = (f32x4){0.f, 0.f, 0.f, 0.f}; }
#pragma unroll
        for (int ks = 0; ks < KS; ++ks)
#pragma unroll
            for (int j = 0; j < 4; ++j) { const bf16x8 kf = *(const LAS bf16x8*)(Kl + (16 * j + fr) * KP + 32 * ks + 8 * fq);
#pragma unroll
                for (int g = 0; g < QG; ++g) s[g][j] = __builtin_amdgcn_mfma_f32_16x16x32_bf16(kf, qf[g][ks], s[g][j], 0, 0, 0); }
        bf16x8 pf[QG][2];
#pragma unroll
        for (int g = 0; g < QG; ++g) {
            const int q0g = q0 + 16 * g;
            if (FOX && kt * 64 + 63 > q0g) {
#pragma unroll
                for (int j = 0; j < 4; ++j)
#pragma unroll
                    for (int r = 0; r < 4; ++r) { const int key = kt * 64 + 16 * j + 4 * fq + r; if (key > q0g + fr) s[g][j][r] = -INFINITY; }
            }
            float mx = fmaxf(fmaxf(s[g][0][0], s[g][0][1]), fmaxf(s[g][0][2], s[g][0][3]));
#pragma unroll
            for (int j = 1; j < 4; ++j) mx = fmaxf(mx, fmaxf(fmaxf(s[g][j][0], s[g][j][1]), fmaxf(s[g][j][2], s[g][j][3])));
            mx = fmaxf(mx, __shfl_xor(mx, 16)); mx = fmaxf(mx, __shfl_xor(mx, 32));
            const float mnew = fmaxf(mrun[g], mx);
            const float alpha = __builtin_amdgcn_exp2f(mrun[g] - mnew);
            mrun[g] = mnew;
            float ls = 0.f;
#pragma unroll
            for (int j = 0; j < 4; ++j)
#pragma unroll
                for (int r = 0; r < 4; ++r) { s[g][j][r] = __builtin_amdgcn_exp2f(s[g][j][r] - mnew); ls += s[g][j][r]; }
            lrun[g] = lrun[g] * alpha + ls;
#pragma unroll
            for (int dj = 0; dj < DJ; ++dj) o[g][dj] = o[g][dj] * alpha;
#pragma unroll
            for (int k2 = 0; k2 < 2; ++k2) { u32x4 w; w.x = cvt_pk_bf16(s[g][2 * k2][0], s[g][2 * k2][1]); w.y = cvt_pk_bf16(s[g][2 * k2][2], s[g][2 * k2][3]);
                w.z = cvt_pk_bf16(s[g][2 * k2 + 1][0], s[g][2 * k2 + 1][1]); w.w = cvt_pk_bf16(s[g][2 * k2 + 1][2], s[g][2 * k2 + 1][3]); pf[g][k2] = __builtin_bit_cast(bf16x8, w); }
        }
#pragma unroll
        for (int dj = 0; dj < DJ; ++dj)
#pragma unroll
            for (int k2 = 0; k2 < 2; ++k2) { const u32x2 lo = *(const LAS u32x2*)(Vl + (16 * dj + fr) * VP + 32 * k2 + 4 * fq), hi = *(const LAS u32x2*)(Vl + (16 * dj + fr) * VP + 32 * k2 + 16 + 4 * fq);
                const u32x4 w = (u32x4){lo.x, lo.y, hi.x, hi.y};
#pragma unroll
                for (int g = 0; g < QG; ++g) o[g][dj] = __builtin_amdgcn_mfma_f32_16x16x32_bf16(__builtin_bit_cast(bf16x8, w), pf[g][k2], o[g][dj], 0, 0, 0); }
    }
#undef ATT_GLOAD
#pragma unroll
    for (int g = 0; g < QG; ++g) {
        float l = lrun[g]; l += __shfl_xor(l, 16); l += __shfl_xor(l, 32);
        const float inv = 1.0f / l;
#pragma unroll
        for (int dj = 0; dj < DJ; ++dj) { u32x2 w; w.x = cvt_pk_bf16(o[g][dj][0] * inv, o[g][dj][1] * inv); w.y = cvt_pk_bf16(o[g][dj][2] * inv, o[g][dj][3] * inv);
            *(u32x2*)(O + (size_t)(q0 + 16 * g + fr) * ldo + 16 * dj + 4 * fq) = w; } }
    __syncthreads();
}

__device__ __forceinline__ void fox_prep(LAS unsigned char* lds, const Params& P, int bh, int tid, int wid, int lane) {
    LAS float* WS = (LAS float*)lds;
    LAS float* E = WS + 16;
    LAS float* F0 = E + 128;
    LAS unsigned* MX = (LAS unsigned*)(F0 + 64);
    const int b = bh >> 3, h = bh & 7;
    const float* SM = (const float*)(P.ws + WS_SM); float* FC = (float*)(P.ws + WS_FC) + (size_t)bh * SEQ;
    const bf16_t* PJ = (const bf16_t*)(P.ws + WS_BIG);
    const float bias = P.in[9][h];
    if (tid < 2) MX[tid] = 0u;
    float pre[16]; float run = 0.f;
#pragma unroll
    for (int i = 0; i < 16; ++i) { const float x = SM[(size_t)(b * SEQ + 16 * tid + i) * 16 + h] + bias; const float ls = -softplus_f(-x) * LOG2E; run += ls; pre[i] = run; }
    float sc = run;
#pragma unroll
    for (int off = 1; off < 64; off <<= 1) { const float v = __shfl_up(sc, off); if (lane >= off) sc += v; }
    if (lane == 63) WS[wid] = sc;
    __syncthreads();
    float base = sc - run;
    for (int w = 0; w < wid; ++w) base += WS[w];
#pragma unroll
    for (int i = 0; i < 16; ++i) { pre[i] += base; FC[16 * tid + i] = pre[i]; }
    if ((tid & 3) == 3) E[tid >> 2] = pre[15];
    if ((tid & 7) == 0) F0[tid >> 3] = pre[0];
    float mq = 0.f, mk = 0.f;
    for (int i = 0; i < 16; ++i) { const bf16_t* qrow = PJ + (size_t)(b * SEQ + 16 * tid + i) * 3072 + h * 64; float sq = 0.f, sk = 0.f;
#pragma unroll
        for (int c = 0; c < 8; ++c) { const u32x4 a = *(const u32x4*)(qrow + 8 * c), k4 = *(const u32x4*)(qrow + 512 + 8 * c);
#pragma unroll
            for (int e = 0; e < 4; ++e) { const float a0 = bflo(a[e]), a1 = bfhi(a[e]), k0 = bflo(k4[e]), k1 = bfhi(k4[e]); sq += a0 * a0 + a1 * a1; sk += k0 * k0 + k1 * k1; } }
        mq = fmaxf(mq, sq); mk = fmaxf(mk, sk); }
    atomicMax((unsigned*)MX, __float_as_uint(mq)); atomicMax((unsigned*)MX + 1, __float_as_uint(mk));
    __syncthreads();
    if (tid < 64) { const float bound = 2.0f * sqrtf(__uint_as_float(MX[0]) * __uint_as_float(MX[1])) * 1.01f + 1.0f;
        const float f0 = F0[tid]; int kt = 0; while (kt < 2 * tid && f0 - E[kt] + bound < -FOX_T2) ++kt;
        ((int*)(P.ws + WS_MISC + MISC_KT0))[bh * 64 + tid] = kt; }
    __syncthreads();
}

constexpr int GP_KL = 0, GP_QL = 17408, GP_RHS = 34816, RHSP = 260, GP_LL = GP_RHS + 64 * RHSP * 4, GP_GC = GP_LL + 16384, GP_BETA = GP_GC + 256, GP_CW = GP_BETA + 256;
__device__ __forceinline__ void gdn_prep_chunk(LAS unsigned char* lds, const Params& P, int ci, int tid, int wid, int lane) {
    LAS bf16_t* Kl = (LAS bf16_t*)(lds + GP_KL); LAS bf16_t* Ql = (LAS bf16_t*)(lds + GP_QL); LAS float* RHS = (LAS float*)(lds + GP_RHS); LAS float* Ll = (LAS float*)(lds + GP_LL);
    LAS float* GC = (LAS float*)(lds + GP_GC); LAS float* BETA = (LAS float*)(lds + GP_BETA); LAS float* CW = (LAS float*)(lds + GP_CW);
    const float* SM = (const float*)(P.ws + WS_SM); const bf16_t* PJ = (const bf16_t*)(P.ws + WS_BIG);
    const int t = tid >> 3, cg8 = tid & 7, ch0 = 16 * cg8;
    float ga_n = 0.f, gb_n = 0.f;
    if (wid == 0) { const size_t R_ = (size_t)(ci >> 9) * SEQ + (size_t)(ci & 127) * 64 + lane; ga_n = SM[R_ * 16 + 12 + ((ci >> 7) & 3)]; gb_n = SM[R_ * 16 + 8 + ((ci >> 7) & 3)]; }
    {
    const int h = (ci >> 7) & 3, c = ci & 127;
    bf16_t* NW = (bf16_t*)(P.ws + WS_NW) + (size_t)ci * 8192; bf16_t* QD = (bf16_t*)(P.ws + WS_QD) + (size_t)ci * 8192; bf16_t* ATT = (bf16_t*)(P.ws + WS_ATT) + (size_t)ci * 4096;
    bf16_t* KTT = (bf16_t*)(P.ws + WS_KTT) + (size_t)ci * 8192; bf16_t* UT = (bf16_t*)(P.ws + WS_UT) + (size_t)ci * 8192;
    if (wid == 0) {
        float g = -__expf(P.in[11][h]) * softplus_f(ga_n + P.in[12][h]);
#pragma unroll
        for (int off = 1; off < 64; off <<= 1) { const float v = __shfl_up(g, off); if (lane >= off) g += v; }
        GC[lane] = g; BETA[lane] = 1.0f / (1.0f + __expf(-gb_n));
        if (lane == 63) ((float*)(P.ws + WS_MISC + MISC_EGL))[ci] = __expf(g);
    }
    __syncthreads();
    {
        float y[3][16];
#pragma unroll
        for (int mat = 0; mat < 3; ++mat) {
#pragma unroll
            for (int e = 0; e < 16; ++e) y[mat][e] = 0.f;
            const bf16_t* src0 = PJ + ((size_t)(ci >> 9) * SEQ + c * 64 + t) * 3072 + 1024 + 512 * mat + h * 128 + ch0;
            const LAS float* wsrc0 = CW + 512 * mat + h * 128 + ch0;
            if (c * 64 + t >= 3) {
                u32x4 xr[4][2];
#pragma unroll
                for (int i = 0; i < 4; ++i) { xr[i][0] = *(const u32x4*)(src0 + (i - 3) * 3072); xr[i][1] = *(const u32x4*)(src0 + (i - 3) * 3072 + 8); }
#pragma unroll
                for (int i = 0; i < 4; ++i) { const u32x4 x0 = xr[i][0], x1 = xr[i][1];
#pragma unroll
                    for (int e = 0; e < 4; ++e) { const f32x4 w4 = *(const LAS f32x4*)(wsrc0 + i * 1536 + 4 * e); const unsigned xa = (e < 2) ? x0[2 * e] : x1[2 * e - 4], xb = (e < 2) ? x0[2 * e + 1] : x1[2 * e - 3];
                        y[mat][4 * e + 0] += w4.x * bflo(xa); y[mat][4 * e + 1] += w4.y * bfhi(xa); y[mat][4 * e + 2] += w4.z * bflo(xb); y[mat][4 * e + 3] += w4.w * bfhi(xb); } }
            } else {
#pragma unroll
                for (int i = 0; i < 4; ++i) { const int tt = c * 64 + t - 3 + i;
                    if (tt >= 0) { const u32x4 x0 = *(const u32x4*)(src0 + (i - 3) * 3072), x1 = *(const u32x4*)(src0 + (i - 3) * 3072 + 8);
#pragma unroll
                        for (int e = 0; e < 4; ++e) { const f32x4 w4 = *(const LAS f32x4*)(wsrc0 + i * 1536 + 4 * e); const unsigned xa = (e < 2) ? x0[2 * e] : x1[2 * e - 4], xb = (e < 2) ? x0[2 * e + 1] : x1[2 * e - 3];
                            y[mat][4 * e + 0] += w4.x * bflo(xa); y[mat][4 * e + 1] += w4.y * bfhi(xa); y[mat][4 * e + 2] += w4.z * bflo(xb); y[mat][4 * e + 3] += w4.w * bfhi(xb); } } }
            }
#pragma unroll
            for (int e = 0; e < 16; ++e) y[mat][e] = pg8::silu_f(y[mat][e]);
        }
        float sq = 0.f, sk = 0.f;
#pragma unroll
        for (int e = 0; e < 16; ++e) { sq += y[0][e] * y[0][e]; sk += y[1][e] * y[1][e]; }
#pragma unroll
        for (int o = 1; o < 8; o <<= 1) { sq += __shfl_xor(sq, o); sk += __shfl_xor(sk, o); }
        const float rq = rsqrtf(sq + EPSN) * 0.08838834764831845f, rk = rsqrtf(sk + EPSN);
        const float gct = GC[t], bt = BETA[t], egt = __expf(gct);
#pragma unroll
        for (int e = 0; e < 16; ++e) { y[0][e] *= rq; y[1][e] *= rk; }
        u32x4 w0, w1;
        w0.x = cvt_pk_bf16(y[1][0], y[1][1]); w0.y = cvt_pk_bf16(y[1][2], y[1][3]); w0.z = cvt_pk_bf16(y[1][4], y[1][5]); w0.w = cvt_pk_bf16(y[1][6], y[1][7]);
        w1.x = cvt_pk_bf16(y[1][8], y[1][9]); w1.y = cvt_pk_bf16(y[1][10], y[1][11]); w1.z = cvt_pk_bf16(y[1][12], y[1][13]); w1.w = cvt_pk_bf16(y[1][14], y[1][15]);
        *(LAS u32x4*)(Kl + t * 136 + ch0) = w0; *(LAS u32x4*)(Kl + t * 136 + ch0 + 8) = w1;
        w0.x = cvt_pk_bf16(y[0][0], y[0][1]); w0.y = cvt_pk_bf16(y[0][2], y[0][3]); w0.z = cvt_pk_bf16(y[0][4], y[0][5]); w0.w = cvt_pk_bf16(y[0][6], y[0][7]);
        w1.x = cvt_pk_bf16(y[0][8], y[0][9]); w1.y = cvt_pk_bf16(y[0][10], y[0][11]); w1.z = cvt_pk_bf16(y[0][12], y[0][13]); w1.w = cvt_pk_bf16(y[0][14], y[0][15]);
        *(LAS u32x4*)(Ql + t * 136 + ch0) = w0; *(LAS u32x4*)(Ql + t * 136 + ch0 + 8) = w1;
#pragma unroll
        for (int e = 0; e < 4; ++e) { *(LAS f32x4*)(RHS + t * RHSP + ch0 + 4 * e) = (f32x4){bt * y[2][4 * e], bt * y[2][4 * e + 1], bt * y[2][4 * e + 2], bt * y[2][4 * e + 3]};
            const float be = bt * egt; *(LAS f32x4*)(RHS + t * RHSP + 128 + ch0 + 4 * e) = (f32x4){be * y[1][4 * e], be * y[1][4 * e + 1], be * y[1][4 * e + 2], be * y[1][4 * e + 3]}; }
#pragma unroll
        for (int e = 0; e < 4; ++e) { u32x2 w; w.x = cvt_pk_bf16(y[0][4 * e] * egt, y[0][4 * e + 1] * egt); w.y = cvt_pk_bf16(y[0][4 * e + 2] * egt, y[0][4 * e + 3] * egt);
            *(u32x2*)(QD + t * 128 + 32 * (cg8 >> 1) + 8 * e + 4 * (cg8 & 1)) = w; }
    }
    __syncthreads();
    {
        const int fr = lane & 15, fq = lane >> 4, ti = wid >> 1, jp = wid & 1;
        f32x4 kk[2], qk[2];
#pragma unroll
        for (int e = 0; e < 2; ++e) { kk[e] = (f32x4){0.f, 0.f, 0.f, 0.f}; qk[e] = (f32x4){0.f, 0.f, 0.f, 0.f}; }
#pragma unroll
        for (int ks = 0; ks < 4; ++ks) { const bf16x8 bK = *(const LAS bf16x8*)(Kl + (16 * ti + fr) * 136 + 32 * ks + 8 * fq), bQ = *(const LAS bf16x8*)(Ql + (16 * ti + fr) * 136 + 32 * ks + 8 * fq);
#pragma unroll
            for (int e = 0; e < 2; ++e) { const bf16x8 a = *(const LAS bf16x8*)(Kl + (16 * (2 * jp + e) + fr) * 136 + 32 * ks + 8 * fq);
                kk[e] = __builtin_amdgcn_mfma_f32_16x16x32_bf16(a, bK, kk[e], 0, 0, 0); qk[e] = __builtin_amdgcn_mfma_f32_16x16x32_bf16(a, bQ, qk[e], 0, 0, 0); } }
        const int t = 16 * ti + fr; const float gct = GC[t];
        float av[8];
#pragma unroll
        for (int e = 0; e < 2; ++e) { f32x4 lv;
#pragma unroll
            for (int r = 0; r < 4; ++r) { const int s = 16 * (2 * jp + e) + 4 * fq + r; const float gcs = GC[s]; const float dec = __expf(fminf(gct - gcs, 0.f)), dec2 = __expf(fminf(gcs - gct, 0.f));
                lv[r] = (t < s) ? BETA[s] * kk[e][r] * dec2 : 0.f; av[4 * e + r] = (s <= t) ? qk[e][r] * dec : 0.f; }
            *(LAS f32x4*)(Ll + t * 64 + 16 * (2 * jp + e) + 4 * fq) = lv; }
        u32x4 w; w.x = cvt_pk_bf16(av[0], av[1]); w.y = cvt_pk_bf16(av[2], av[3]); w.z = cvt_pk_bf16(av[4], av[5]); w.w = cvt_pk_bf16(av[6], av[7]);
        *(u32x4*)(ATT + t * 64 + 32 * jp + 8 * fq) = w;
    }
    __syncthreads();
    if (wid < 4) {
        const int col = 64 * wid + lane;
        int vz; asm volatile("v_mov_b32 %0, 0" : "=v"(vz));
        const LAS float* Lz = Ll + 4 * vz;
        float x[64];
#pragma unroll
        for (int i = 0; i < 64; ++i) x[i] = RHS[i * RHSP + col];
#pragma unroll
        for (int m = 0; m < 63; ++m) { const float xm = x[m];
#pragma unroll
            for (int g4 = (m + 1) / 4; g4 < 16; ++g4) { const f32x4 l4 = *(const LAS f32x4*)(Lz + m * 64 + 4 * g4);
                x[4 * g4] -= l4.x * xm; x[4 * g4 + 1] -= l4.y * xm; x[4 * g4 + 2] -= l4.z * xm; x[4 * g4 + 3] -= l4.w * xm; } }
        if (wid < 2) {
#pragma unroll
            for (int j = 0; j < 8; ++j) { u32x4 w; w.x = cvt_pk_bf16(x[8 * j], x[8 * j + 1]); w.y = cvt_pk_bf16(x[8 * j + 2], x[8 * j + 3]); w.z = cvt_pk_bf16(x[8 * j + 4], x[8 * j + 5]); w.w = cvt_pk_bf16(x[8 * j + 6], x[8 * j + 7]);
                *(u32x4*)(UT + col * 64 + 8 * j) = w; }
        } else {
            const int dk = col - 128, o = dk & 31; const int pos = (dk & ~31) + ((o < 16) ? (8 * (o >> 2) + (o & 3)) : (8 * ((o - 16) >> 2) + 4 + (o & 3)));
#pragma unroll
            for (int i = 0; i < 64; ++i) Ql[i * 136 + pos] = (bf16_t)(cvt_pk_bf16(-x[i], 0.f) & 0xffffu);
        }
    } else {
        const int idx = tid - 256, dk = idx >> 1, th = idx & 1; const float gl = GC[63];
        float v[32];
#pragma unroll
        for (int pos = 0; pos < 32; ++pos) { const int a = pos >> 3, s = pos & 7; const int o = (s < 4) ? (4 * a + s) : (16 + 4 * a + s - 4); const int t = 32 * th + o;
            v[pos] = bf2f(Kl[t * 136 + dk]) * __expf(gl - GC[t]); }
#pragma unroll
        for (int j = 0; j < 4; ++j) { u32x4 w; w.x = cvt_pk_bf16(v[8 * j], v[8 * j + 1]); w.y = cvt_pk_bf16(v[8 * j + 2], v[8 * j + 3]); w.z = cvt_pk_bf16(v[8 * j + 4], v[8 * j + 5]); w.w = cvt_pk_bf16(v[8 * j + 6], v[8 * j + 7]);
            *(u32x4*)(KTT + dk * 64 + 32 * th + 8 * j) = w; }
    }
    __syncthreads();
#pragma unroll
    for (int i = 0; i < 2; ++i) { const int p = tid + 512 * i; *(u32x4*)(NW + (p >> 4) * 128 + (p & 15) * 8) = *(const LAS u32x4*)(Ql + (p >> 4) * 136 + (p & 15) * 8); }
    }
}

constexpr int GS_NW = 0, GS_QD = 17408, GS_ATT = 34816, GS_KTT = 44032, GS_UT = 62464, GS_OL = 80896;
__device__ __forceinline__ void gdn_scan(LAS unsigned char* lds, const Params& P, int bh, int half, int tid, int wid, int lane) {
    LAS bf16_t* NWl = (LAS bf16_t*)(lds + GS_NW); LAS bf16_t* QDl = (LAS bf16_t*)(lds + GS_QD); LAS bf16_t* ATTl = (LAS bf16_t*)(lds + GS_ATT);
    LAS bf16_t* KTTl = (LAS bf16_t*)(lds + GS_KTT); LAS bf16_t* UTl = (LAS bf16_t*)(lds + GS_UT); LAS float* OL = (LAS float*)(lds + GS_OL);
    const int b = bh >> 2, h = bh & 3, fr = lane & 15, fq = lane >> 4;
    bf16_t* ORAW = (bf16_t*)(P.ws + WS_ORAW); const int dvw = 64 * half + 16 * wid;
    const float* EGL = (const float*)(P.ws + WS_MISC + MISC_EGL) + (size_t)bh * 128;
    const u32x4* gNW = (const u32x4*)(P.ws + WS_NW) + (size_t)bh * 128 * 1024; const u32x4* gQD = (const u32x4*)(P.ws + WS_QD) + (size_t)bh * 128 * 1024;
    const u32x4* gATT = (const u32x4*)(P.ws + WS_ATT) + (size_t)bh * 128 * 512; const u32x4* gKTT = (const u32x4*)(P.ws + WS_KTT) + (size_t)bh * 128 * 1024; const u32x4* gUT = (const u32x4*)(P.ws + WS_UT) + (size_t)bh * 128 * 1024;
    const int ot = tid >> 3, og = tid & 7;
    f32x4 Sacc[8];
#pragma unroll
    for (int m = 0; m < 8; ++m) Sacc[m] = (f32x4){0.f, 0.f, 0.f, 0.f};
    u32x4 rNW[2], rQD[2], rATT, rKTT[2], rUT[2]; float egl_n;
#define GS_GLOAD(c) do { _Pragma("unroll") for (int i_ = 0; i_ < 2; ++i_) { rNW[i_] = gNW[(size_t)(c) * 1024 + tid + 512 * i_]; rQD[i_] = gQD[(size_t)(c) * 1024 + tid + 512 * i_]; \
        rKTT[i_] = gKTT[(size_t)(c) * 1024 + tid + 512 * i_]; rUT[i_] = gUT[(size_t)(c) * 1024 + tid + 512 * i_]; } rATT = gATT[(size_t)(c) * 512 + tid]; egl_n = EGL[c]; } while (0)
    GS_GLOAD(0);
    for (int c = 0; c < 128; ++c) {
#pragma unroll
        for (int i = 0; i < 2; ++i) { const int p = tid + 512 * i;
            *(LAS u32x4*)(NWl + (p >> 4) * 136 + (p & 15) * 8) = rNW[i]; *(LAS u32x4*)(QDl + (p >> 4) * 136 + (p & 15) * 8) = rQD[i];
            *(LAS u32x4*)(KTTl + (p >> 3) * 72 + (p & 7) * 8) = rKTT[i]; *(LAS u32x4*)(UTl + (p >> 3) * 72 + (p & 7) * 8) = rUT[i]; }
        *(LAS u32x4*)(ATTl + (tid >> 3) * 72 + (tid & 7) * 8) = rATT;
        const float egl = egl_n;
        __syncthreads();
        if (c + 1 < 128) GS_GLOAD(c + 1);
        const size_t R = (size_t)b * SEQ + (size_t)c * 64 + ot;
        if (wid < 4) {
        bf16x8 Bs[4];
#pragma unroll
        for (int ks = 0; ks < 4; ++ks) { u32x4 w; w.x = cvt_pk_bf16(Sacc[2 * ks][0], Sacc[2 * ks][1]); w.y = cvt_pk_bf16(Sacc[2 * ks][2], Sacc[2 * ks][3]);
            w.z = cvt_pk_bf16(Sacc[2 * ks + 1][0], Sacc[2 * ks + 1][1]); w.w = cvt_pk_bf16(Sacc[2 * ks + 1][2], Sacc[2 * ks + 1][3]); Bs[ks] = __builtin_bit_cast(bf16x8, w); }
        f32x4 VN[4], OA[4];
#pragma unroll
        for (int mt = 0; mt < 4; ++mt) { const u32x2 u2 = *(const LAS u32x2*)(UTl + (dvw + fr) * 72 + 16 * mt + 4 * fq);
            VN[mt] = (f32x4){bflo(u2.x), bfhi(u2.x), bflo(u2.y), bfhi(u2.y)}; OA[mt] = (f32x4){0.f, 0.f, 0.f, 0.f}; }
#pragma unroll
        for (int ks = 0; ks < 4; ++ks)
#pragma unroll
            for (int mt = 0; mt < 4; ++mt) { const bf16x8 a = *(const LAS bf16x8*)(NWl + (16 * mt + fr) * 136 + 32 * ks + 8 * fq), q = *(const LAS bf16x8*)(QDl + (16 * mt + fr) * 136 + 32 * ks + 8 * fq);
                VN[mt] = __builtin_amdgcn_mfma_f32_16x16x32_bf16(a, Bs[ks], VN[mt], 0, 0, 0); OA[mt] = __builtin_amdgcn_mfma_f32_16x16x32_bf16(q, Bs[ks], OA[mt], 0, 0, 0); }
        bf16x8 Bv[2];
#pragma unroll
        for (int k2 = 0; k2 < 2; ++k2) { u32x4 w; w.x = cvt_pk_bf16(VN[2 * k2][0], VN[2 * k2][1]); w.y = cvt_pk_bf16(VN[2 * k2][2], VN[2 * k2][3]);
            w.z = cvt_pk_bf16(VN[2 * k2 + 1][0], VN[2 * k2 + 1][1]); w.w = cvt_pk_bf16(VN[2 * k2 + 1][2], VN[2 * k2 + 1][3]); Bv[k2] = __builtin_bit_cast(bf16x8, w); }
#pragma unroll
        for (int k2 = 0; k2 < 2; ++k2)
#pragma unroll
            for (int mt = 0; mt < 4; ++mt) { const bf16x8 a = *(const LAS bf16x8*)(ATTl + (16 * mt + fr) * 72 + 32 * k2 + 8 * fq);
                OA[mt] = __builtin_amdgcn_mfma_f32_16x16x32_bf16(a, Bv[k2], OA[mt], 0, 0, 0); }
#pragma unroll
        for (int m = 0; m < 8; ++m) Sacc[m] = Sacc[m] * egl;
#pragma unroll
        for (int k2 = 0; k2 < 2; ++k2)
#pragma unroll
            for (int m = 0; m < 8; ++m) { const bf16x8 a = *(const LAS bf16x8*)(KTTl + (16 * m + fr) * 72 + 32 * k2 + 8 * fq);
                Sacc[m] = __builtin_amdgcn_mfma_f32_16x16x32_bf16(a, Bv[k2], Sacc[m], 0, 0, 0); }
#pragma unroll
        for (int mt = 0; mt < 4; ++mt)
#pragma unroll
            for (int r = 0; r < 4; ++r) OL[(16 * mt + 4 * fq + r) * 132 + 16 * wid + fr] = OA[mt][r];
        }
        __syncthreads();
        {
            const f32x4 a = *(const LAS f32x4*)(OL + ot * 132 + 8 * og), b2 = *(const LAS f32x4*)(OL + ot * 132 + 8 * og + 4);
            u32x4 w; w.x = cvt_pk_bf16(a.x, a.y); w.y = cvt_pk_bf16(a.z, a.w); w.z = cvt_pk_bf16(b2.x, b2.y); w.w = cvt_pk_bf16(b2.z, b2.w);
            *(u32x4*)(ORAW + R * 512 + h * 128 + 64 * half + 8 * og) = w;
        }
    }
#undef GS_GLOAD
    __syncthreads();
}

#if defined(__HIP_DEVICE_COMPILE__)
__device__ __forceinline__ Params getp() { auto k = __builtin_amdgcn_kernarg_segment_ptr(); asm volatile("" : "+s"(k)); return *(const Params __attribute__((address_space(4)))*)k; }
#else
__device__ __forceinline__ Params getp() { return Params{}; }
#endif
#define GEMM_BF16(Aptr, Bptr, M_, N_, K_, Optr, ldc_, scale_, coff_) do { const Params P = getp(); unsigned char* ws = P.ws; (void)ws; \
        pg8::Gemm g{(const bf16_t*)(Aptr), (const bf16_t*)(Bptr), (M_), (N_), (K_)}; pg8::StaticOrder S; S.init((M_), (N_), G, (bid + (coff_)) % G); pg8::EpiBf16 E{(bf16_t*)(Optr), (ldc_), (scale_)}; \
        _Pragma("unroll") for (int rep_ = 0; rep_ < GEMM_REPS; ++rep_) pg8::gemm_phase<pg8::EpiBf16, pg8::StaticOrder, true, true>(lds, g, S, E); } while (0)
#define GEMM_MAP(LDC_, Aptr, Bptr, M_, N_, K_, bbs_, bsh_, Optr, sh_, looff_, hioff_, pnoff_, scale_, coff_) do { const Params P = getp(); unsigned char* ws = P.ws; (void)ws; \
        int kv_ = (K_); asm volatile("" : "+s"(kv_));     \
        pg8::Gemm g{(const bf16_t*)(Aptr), (const bf16_t*)(Bptr), (M_), (N_), kv_, (size_t)(bbs_), (bsh_)}; pg8::StaticOrder S; S.init((M_), (N_), G, (bid + (coff_)) % G); \
        pg8::EpiBf16Map<LDC_> E{(bf16_t*)(Optr), (sh_), (size_t)(looff_), (size_t)(hioff_), (size_t)(pnoff_), (scale_)}; \
        pg8::gemm_phase<pg8::EpiBf16Map<LDC_>, pg8::StaticOrder, true, true>(lds, g, S, E); } while (0)
#define GEMM_SWIGLU(Bptr) do { const Params P = getp(); unsigned char* ws = P.ws; \
        pg8::Gemm g{(const bf16_t*)(ws + WS_A), (const bf16_t*)(Bptr), MTOK, 2 * DFF, DM}; pg8::StaticOrder S; S.init(MTOK, 2 * DFF, G, bid); pg8::EpiSwiGLU E{(bf16_t*)(ws + WS_BIG), DFF}; \
        _Pragma("unroll") for (int rep_ = 0; rep_ < GEMM_REPS; ++rep_) pg8::gemm_phase<pg8::EpiSwiGLU, pg8::StaticOrder, true, true>(lds, g, S, E); } while (0)
#define GEMM_FUSED(Aptr, Bptr, K_, hin_, gpost_, w_, gnext_, hasA_, e_) do { const Params P = getp(); unsigned char* ws = P.ws; \
        pg8::Gemm g{(const bf16_t*)(Aptr), (const bf16_t*)(Bptr), MTOK, DM, (K_)}; pg8::StaticOrder S; S.init(MTOK, DM, G, bid); \
        pg8::EpiRmsRes E{(hin_), P.out, (hasA_) ? (bf16_t*)(ws + WS_A) : nullptr, (gpost_), (gnext_), (w_), EPSN, (float*)(ws + WS_XS + (size_t)(e_) * XS_BYTES), (unsigned*)(ws + WS_XCNT), 32u * ((e_) + 1), lds + 131072}; \
        pg8::gemm_phase<pg8::EpiRmsRes, pg8::StaticOrder, true, true>(lds, g, S, E); } while (0)
#define ROW_F_OFF WS_F
#define ROW_PHASE(hin_, gpost_, w_, gnext_, hasA_, mode_) do { PH_IDS const Params P = getp(); unsigned char* ws = P.ws; bf16_t* HB = (bf16_t*)(ws + WS_HB); bf16_t* OB = (bf16_t*)P.out; \
        row_phase(((mode_) == 0 || (mode_) == 1 || (mode_) == 4) ? (hin_) : nullptr, ((mode_) == 2 || (mode_) == 3) ? HB : ((mode_) == 5 ? OB : nullptr), (const bf16_t*)(ws + ROW_F_OFF), (gpost_), (w_), \
                  ((mode_) == 0 || (mode_) == 3) ? P.out : nullptr, ((mode_) == 1 || (mode_) == 2 || (mode_) == 5) ? HB : ((mode_) == 4 ? OB : nullptr), \
                  (gnext_), (hasA_) ? (bf16_t*)(ws + WS_A) : nullptr, MTOK, gw, ngw, lane); } while (0)
#if defined(TS_SEL)
#define GSYNC() do { cg::this_grid().sync(); if (blockIdx.x == 0 && threadIdx.x == 0) { const Params Pt = getp(); ((unsigned long long*)(Pt.ws + WS_CTL + 16384))[ts_k] = __builtin_amdgcn_s_memrealtime(); } ++ts_k; } while (0)
#else
#if defined(USE_CG_ONLY)
#define GSYNC() cg::this_grid().sync()
#else
#define GSYNC() do { const Params Pb = getp(); XcdBarrier xb_; xb_.bar = (unsigned*)(Pb.ws + WS_XBAR); xb_.x = xb_xcc_id(); xb_.st = (volatile LAS unsigned*)(lds + LDS_BCAST + 64); xcd_barrier(xb_); } while (0)
#endif
#endif
#if defined(TS_SEL)
#define TS_STAMP0() do { if (blockIdx.x == 0 && threadIdx.x == 0) { const Params Pt = getp(); ((unsigned long long*)(Pt.ws + WS_CTL + 16384))[ts_k] = __builtin_amdgcn_s_memrealtime(); } ++ts_k; } while (0)
#else
#define TS_STAMP0() do { } while (0)
#endif
#define GSYNC0() do { cg::this_grid().sync(); { const Params Pb = getp(); (void)xcd_barrier_post((unsigned*)(Pb.ws + WS_XBAR), (volatile LAS unsigned*)(lds + LDS_BCAST + 64)); } TS_STAMP0(); } while (0)
#ifndef GEMM_REPS
#define GEMM_REPS 1
#endif

__global__ void __launch_bounds__(512, 2) hymba_fwd(Params Parg) {
    extern __shared__ __attribute__((aligned(16))) unsigned char lds_raw[];
    LAS unsigned char* lds = (LAS unsigned char*)lds_raw;
    const int G = gridDim.x, bid = blockIdx.x;
    if (threadIdx.x < 2) ((volatile LAS unsigned*)(lds + LDS_BCAST + 64))[threadIdx.x] = 0u;
#if defined(TS_SEL)
    int ts_k = 0;
    if (blockIdx.x == 0 && threadIdx.x == 0) { const Params Pt = getp(); ((unsigned long long*)(Pt.ws + WS_CTL + 16384))[31] = __builtin_amdgcn_s_memrealtime(); }
#endif
#define PH_IDS int tid_l = threadIdx.x; asm volatile("" : "+v"(tid_l)); const int tid = tid_l, lane = tid & 63, wid = __builtin_amdgcn_readfirstlane(tid >> 6), gw = bid * 8 + wid, ngw = G * 8; (void)gw; (void)ngw; (void)lane; \
        volatile LAS unsigned* bc = (volatile LAS unsigned*)(lds + LDS_BCAST); (void)bc;

    {
        PH_IDS const Params P = getp(); unsigned char* ws = P.ws;
        LAS float* scr = (LAS float*)(lds + wid * 16384);
        if (bid == 0 && tid < 64) { unsigned* ctl = (unsigned*)(ws + WS_CTL); ctl[64 * tid] = 0u; }
        if (bid == 0) { unsigned* xb = (unsigned*)(ws + WS_XBAR); for (int i = tid; i < XCD_BAR_WORDS; i += 512) xb[i] = 0u; }
        if (bid == 0) { unsigned* xc = (unsigned*)(ws + WS_XCNT); for (int i = tid; i < 256 * 64; i += 512) xc[i] = 0u; }
        transpose_all(P.in[3], DM, DFF, (bf16_t*)(ws + WS_WGU1), MapGate{}, scr, gw, ngw, lane);
        transpose_all(P.in[4], DM, DFF, (bf16_t*)(ws + WS_WGU1), MapUp{}, scr, gw, ngw, lane);
        transpose_all(P.in[5], DFF, DM, (bf16_t*)(ws + WS_WD1), MapIdent{0}, scr, gw, ngw, lane);
        transpose_all(P.in[8], DM, 3600, (bf16_t*)(ws + WS_WIN), MapWin{}, scr, gw, ngw, lane);
        transpose_all(P.in[8], DM, 3600, (bf16_t*)(ws + WS_WVT), MapWinV{}, scr, gw, ngw, lane);
        transpose_all(P.in[19], DM, 2 * DM, (bf16_t*)(ws + WS_WKV), MapIdent{0}, scr, gw, ngw, lane);
        {
            u32x4* z = (u32x4*)((bf16_t*)(ws + WS_WIN) + (size_t)3088 * DM); const int n16 = 240 * DM / 8;
            for (int i = bid * 512 + tid; i < n16; i += G * 512) z[i] = (u32x4){0u, 0u, 0u, 0u};
        }
        for (int h = 0; h < 4; ++h) transpose_all(P.in[20] + (size_t)h * 256 * DM, 256, DM, (bf16_t*)(ws + WS_WOTH) + (size_t)h * DM * 256, MapIdent{0}, scr, gw, ngw, lane);
        for (int i = bid * 512 + tid; i < 131072; i += G * 512) { const int h = i >> 15, rem = i & 32767, k = rem >> 5, d8 = rem & 31;
            const float* src = P.in[18] + (size_t)k * DM + h * 256 + d8 * 8; const f32x4 a = *(const f32x4*)src, b2 = *(const f32x4*)(src + 4);
            u32x4 w; w.x = cvt_pk_bf16(a.x, a.y); w.y = cvt_pk_bf16(a.z, a.w); w.z = cvt_pk_bf16(b2.x, b2.y); w.w = cvt_pk_bf16(b2.z, b2.w); ((u32x4*)(ws + WS_WQH))[i] = w; }
        row_phase(P.in[0], nullptr, nullptr, nullptr, 0.f, nullptr, nullptr, P.in[2], (bf16_t*)(ws + WS_A), MTOK, gw, ngw, lane);
        row_phase(P.in[1], nullptr, nullptr, nullptr, 0.f, nullptr, nullptr, P.in[17], (bf16_t*)(ws + WS_AMEM), NB * NMEM, gw, ngw, lane);
    }
    GSYNC0();
#if defined(STOP_AFTER)
    if (STOP_AFTER == 0) return;
#endif
    GEMM_SWIGLU(ws + WS_WGU1);
    GSYNC();
#if defined(STOP_AFTER)
    if (STOP_AFTER == 1) return;
#endif
    GEMM_BF16(ws + WS_BIG, ws + WS_WD1, MTOK, DM, DFF, ws + WS_F, DM, 1.f, 0);
    GSYNC();
#if defined(STOP_AFTER)
    if (STOP_AFTER == 2) return;
#endif
    ROW_PHASE(P.in[0], P.in[6], 0.5f, P.in[7], true, 4);
    GSYNC();
#if defined(STOP_AFTER)
    if (STOP_AFTER == 3) return;
#endif
    { const Params P = getp(); unsigned char* ws = P.ws;
      pg8::Gemm g{(const bf16_t*)(ws + WS_A), (const bf16_t*)(ws + WS_WIN), MTOK, 3328, DM}; pg8::StaticOrder S; S.init(MTOK, 3328, G, bid); pg8::EpiProj E{(bf16_t*)(ws + WS_BIG), (float*)(ws + WS_SM), FOX_QSCALE};
      _Pragma("unroll") for (int rep_ = 0; rep_ < GEMM_REPS; ++rep_) pg8::gemm_phase<pg8::EpiProj, pg8::StaticOrder, true, true>(lds, g, S, E); }
    GEMM_BF16(ws + WS_WVT, ws + WS_A, 512, MTOK, DM, ws + WS_VT, MTOK, 1.f, 0);
    GSYNC();
#if defined(STOP_AFTER)
    if (STOP_AFTER == 4) return;
#endif
    { PH_IDS const Params P = getp();
#ifndef P5_REPS
#define P5_REPS 1
#endif
      {
#ifndef FOXP_REPS
#define FOXP_REPS 1
#endif
      if (bid < 64) { for (int rp = 0; rp < FOXP_REPS; ++rp) fox_prep(lds, P, bid, tid, wid, lane); }
      { LAS float* CW = (LAS float*)(lds + GP_CW); for (int i = tid; i < 6144; i += 512) CW[i] = P.in[10][i]; }
      { unsigned* ctl = (unsigned*)(P.ws + WS_CTL);
      for (;;) { if (tid == 0) *bc = atomicAdd(ctl + 0, 1u); __syncthreads(); const int ci = (int)*bc; __syncthreads(); if (ci >= 4096) break;
          gdn_prep_chunk(lds, P, ci, tid, wid, lane); } } } }
    GSYNC();
#if defined(STOP_AFTER)
    if (STOP_AFTER == 5) return;
#endif
#if defined(DUMP_PREP)
    { PH_IDS const Params P = getp(); unsigned char* ws = P.ws; const bf16_t* s0 = (const bf16_t*)(ws + DUMP_A); const bf16_t* s1 = (const bf16_t*)(ws + DUMP_B);
      for (int i = bid * 512 + tid; i < 4096 * 8192; i += G * 512) { float a = bf2f(s0[i]), b = bf2f(s1[i]); if (!(fabsf(a) < 1e30f)) a = 1e4f; if (!(fabsf(b) < 1e30f)) b = 1e4f;
          if (fabsf(a) > 100.f) a = 3e3f; if (fabsf(b) > 100.f) b = 3e3f; P.out[i] = a; P.out[4096 * 8192 + i] = b; } }
    return;
#endif
    GEMM_MAP(256, ws + WS_AMEM, ws + WS_WKV, NB * NMEM, 2 * DM, DM, 0, 0, ws + WS_KMEM, 30, (size_t)256 * 256, 0, (size_t)2048 * 256, 1.f, 64);
    { PH_IDS const Params P = getp(); unsigned char* ws = P.ws; unsigned* ctl = (unsigned*)(ws + WS_CTL);
#ifndef P6_REPS
#define P6_REPS 1
#endif
      {
#if defined(SKIP_GDN)
      for (int i = bid * 512 + tid; i < MTOK * 64; i += G * 512) { ((u32x4*)(ws + WS_A))[(i >> 6) * 128 + 64 + (i & 63)] = (u32x4){0u, 0u, 0u, 0u}; }
#else
      if (bid < 64) gdn_scan(lds, P, bid >> 1, bid & 1, tid, wid, lane);
#if defined(TS_SEL)
      if (bid == 0 && tid == 0) ((unsigned long long*)(ws + WS_CTL + 16384))[30] = __builtin_amdgcn_s_memrealtime();
#endif
#endif
#if defined(SKIP_FOX)
      for (int i = bid * 512 + tid; i < MTOK * 64; i += G * 512) { ((u32x4*)(ws + WS_A))[(i >> 6) * 128 + (i & 63)] = (u32x4){0u, 0u, 0u, 0u}; }
#endif
      const int* KT0 = (const int*)(ws + WS_MISC + MISC_KT0); const bf16_t* PJ = (const bf16_t*)(ws + WS_BIG);
#if defined(SKIP_FOX)
      if (0)
#endif
      for (;;) { if (tid == 0) *bc = atomicAdd(ctl + 64, 1u); __syncthreads(); const int idx = (int)*bc; __syncthreads(); if (idx >= 2048) break;
          const int qb = 31 - (idx >> 6), bh = idx & 63, b = bh >> 3, h = bh & 7;
          const int kt0 = KT0[bh * 64 + 2 * qb];
          attn_unit<64, true, 2>(lds, PJ + (size_t)b * SEQ * 3072 + h * 64, 3072, PJ + (size_t)b * SEQ * 3072 + 512 + h * 64, 3072,
                              (const bf16_t*)(ws + WS_VT) + (size_t)(h * 64) * MTOK + (size_t)b * SEQ, MTOK, (bf16_t*)(ws + WS_A) + (size_t)b * SEQ * 1024 + h * 64, 1024,
                              (const float*)(ws + WS_FC) + (size_t)bh * SEQ, qb, kt0, 4 * qb + 3, tid, wid, lane); } }
      if (bid >= 64) { LAS float* scr = (LAS float*)(lds + wid * 16384); const int gw2 = (bid - 64) * 8 + wid, ngw2 = (G - 64) * 8;
        transpose_all(P.in[14], DM, DM, (bf16_t*)(ws + WS_WOUT), MapIdent{0}, scr, gw2, ngw2, lane);
        transpose_all(P.in[23], DM, DFF, (bf16_t*)(ws + WS_WGU2), MapGate{}, scr, gw2, ngw2, lane);
        transpose_all(P.in[24], DM, DFF, (bf16_t*)(ws + WS_WGU2), MapUp{}, scr, gw2, ngw2, lane);
        transpose_all(P.in[25], DFF, DM, (bf16_t*)(ws + WS_WD2), MapIdent{0}, scr, gw2, ngw2, lane); }
      }
    GSYNC();
#if defined(STOP_AFTER)
    if (STOP_AFTER == 6) return;
#endif
#if defined(DUMP_MIX)
    { PH_IDS const Params P = getp(); unsigned char* ws = P.ws; const bf16_t* s0 = (const bf16_t*)(ws + WS_A);
      for (int i = bid * 512 + tid; i < MTOK * 1024; i += G * 512) { float a = bf2f(s0[i]); if (!(fabsf(a) < 1e30f)) a = 1e4f; else if (fabsf(a) > 100.f) a = 3e3f;
#if defined(DUMP_MASK0)
          if ((((i >> 10) & 8191) >> 6) == DUMP_MASK0) a = 0.f;
#endif
          P.out[i] = a; } }
    return;
#endif
    GEMM_MAP(1024, ws + WS_KMEM, ws + WS_WQH, 4 * NB * NMEM, DM, 256, (size_t)DM * 256 * 2, 3, ws + WS_MB, 3, (size_t)DM * DM, (size_t)256 * DM, 256, MEM_QSCALE, 0);
    GEMM_MAP(1024, ws + WS_WOTH, ws + WS_VMEMT, 4 * DM, NB * NMEM, 256, (size_t)2048 * 256 * 2, 2, ws + WS_NB, 2, (size_t)256 * DM, 256, (size_t)DM * DM, 1.f, 128);
    { PH_IDS const Params P = getp(); unsigned char* ws = P.ws; const bf16_t* ORAW = (const bf16_t*)(ws + WS_ORAW); const bf16_t* PJ = (const bf16_t*)(ws + WS_BIG); bf16_t* MIX = (bf16_t*)(ws + WS_A);
      for (int it0 = bid * 512 + tid; it0 < MTOK * 32; it0 += 2 * G * 512) {
          u32x4 ld[2][4]; const int og = it0 & 7, h = (it0 >> 3) & 3;
#pragma unroll
          for (int q = 0; q < 2; ++q) { const int it = it0 + q * G * 512; if (it < MTOK * 32) { const size_t R = (size_t)(it >> 5);
              ld[q][0] = *(const u32x4*)(ORAW + R * 512 + h * 128 + 16 * og); ld[q][1] = *(const u32x4*)(ORAW + R * 512 + h * 128 + 16 * og + 8);
              ld[q][2] = *(const u32x4*)(PJ + R * 3072 + 2560 + h * 128 + 16 * og); ld[q][3] = *(const u32x4*)(PJ + R * 3072 + 2560 + h * 128 + 16 * og + 8); } }
#pragma unroll
          for (int q = 0; q < 2; ++q) { const int it = it0 + q * G * 512; if (it < MTOK * 32) { const size_t R = (size_t)(it >> 5);
          const u32x4 o0 = ld[q][0], o1 = ld[q][1], gz0 = ld[q][2], gz1 = ld[q][3];
          float ov[16], z[16]; float ss = 0.f;
#pragma unroll
          for (int e = 0; e < 4; ++e) { ov[2 * e] = bflo(o0[e]); ov[2 * e + 1] = bfhi(o0[e]); ov[8 + 2 * e] = bflo(o1[e]); ov[8 + 2 * e + 1] = bfhi(o1[e]);
              z[2 * e] = bflo(gz0[e]); z[2 * e + 1] = bfhi(gz0[e]); z[8 + 2 * e] = bflo(gz1[e]); z[8 + 2 * e + 1] = bfhi(gz1[e]); }
#pragma unroll
          for (int e = 0; e < 16; ++e) ss += ov[e] * ov[e];
#pragma unroll
          for (int o = 1; o < 8; o <<= 1) ss += __shfl_xor(ss, o);
          const float rs = rsqrtf(ss * (1.0f / 128.0f) + EPSN);
          float r16[16];
#pragma unroll
          for (int e = 0; e < 4; ++e) { const f32x4 gn = *(const f32x4*)(P.in[13] + 16 * og + 4 * e);
              r16[4 * e] = ov[4 * e] * rs * gn.x * pg8::silu_f(z[4 * e]); r16[4 * e + 1] = ov[4 * e + 1] * rs * gn.y * pg8::silu_f(z[4 * e + 1]);
              r16[4 * e + 2] = ov[4 * e + 2] * rs * gn.z * pg8::silu_f(z[4 * e + 2]); r16[4 * e + 3] = ov[4 * e + 3] * rs * gn.w * pg8::silu_f(z[4 * e + 3]); }
          u32x4 w0, w1;
          w0.x = cvt_pk_bf16(r16[0], r16[1]); w0.y = cvt_pk_bf16(r16[2], r16[3]); w0.z = cvt_pk_bf16(r16[4], r16[5]); w0.w = cvt_pk_bf16(r16[6], r16[7]);
          w1.x = cvt_pk_bf16(r16[8], r16[9]); w1.y = cvt_pk_bf16(r16[10], r16[11]); w1.z = cvt_pk_bf16(r16[12], r16[13]); w1.w = cvt_pk_bf16(r16[14], r16[15]);
          bf16_t* dst = MIX + R * 1024 + 512 + h * 128 + 16 * og; *(u32x4*)dst = w0; *(u32x4*)(dst + 8) = w1; } } } }
    GSYNC();
    GEMM_BF16(ws + WS_A, ws + WS_WOUT, MTOK, DM, DM, ws + WS_F, DM, 1.f, 0);
    GSYNC();
#if defined(STOP_AFTER)
    if (STOP_AFTER == 7) return;
#endif
    ROW_PHASE(P.out, P.in[15], 1.0f, P.in[16], true, 5);
    GSYNC();
#if defined(STOP_AFTER)
    if (STOP_AFTER == 8) return;
#endif
    { const Params P = getp(); unsigned char* ws = P.ws;
      pg8::Gemm g{(const bf16_t*)(ws + WS_A), (const bf16_t*)(ws + WS_MB), MTOK, DM, DM, (size_t)DM * DM * 2, 5}; pg8::StaticOrder S; S.init(MTOK, DM, G, bid); pg8::EpiSoftmax E{(bf16_t*)(ws + WS_F), DM, lds + 131072};
      pg8::gemm_phase<pg8::EpiSoftmax, pg8::StaticOrder, true, true>(lds, g, S, E); }
    GSYNC();
#if defined(STOP_AFTER)
    if (STOP_AFTER == 9) return;
#endif
    { const Params P = getp(); unsigned char* ws = P.ws;
      pg8::Gemm g{(const bf16_t*)(ws + WS_F), (const bf16_t*)(ws + WS_NB), MTOK, DM, DM, (size_t)DM * DM * 2, 5}; pg8::StaticOrder S; S.init(MTOK, DM, G, bid); pg8::EpiBf16 E{(bf16_t*)(ws + WS_A), DM, 1.f};
      pg8::gemm_phase<pg8::EpiBf16, pg8::StaticOrder, true, true>(lds, g, S, E); }
    GSYNC();
#if defined(STOP_AFTER)
    if (STOP_AFTER == 11) return;
#endif
#undef ROW_F_OFF
#define ROW_F_OFF WS_A
    ROW_PHASE(P.out, P.in[21], 1.0f, P.in[22], true, 2);
#undef ROW_F_OFF
#define ROW_F_OFF WS_F
    GSYNC();
#if defined(STOP_AFTER)
    if (STOP_AFTER == 12) return;
#endif
    GEMM_SWIGLU(ws + WS_WGU2);
    GSYNC();
#if defined(STOP_AFTER)
    if (STOP_AFTER == 13) return;
#endif
    GEMM_BF16(ws + WS_BIG, ws + WS_WD2, MTOK, DM, DFF, ws + WS_F, DM, 1.f, 0);
    GSYNC();
#if defined(STOP_AFTER)
    if (STOP_AFTER == 14) return;
#endif
    ROW_PHASE(P.out, P.in[26], 0.5f, (const float*)nullptr, false, 3);
#if defined(TS_SEL)
    GSYNC();
    { PH_IDS const Params P = getp(); const unsigned long long* ts = (const unsigned long long*)(P.ws + WS_CTL + 16384);
      float d2 = 1e-3f; if (TS_SEL >= 0 && TS_SEL < 20) { const float us = (float)(ts[TS_SEL] - ts[TS_SEL == 0 ? 31 : TS_SEL - 1]) * 0.01f; d2 = us * 1e-6f; }
      if (TS_SEL == 30) { const float us = (float)(ts[30] - ts[5]) * 0.01f; d2 = us * 1e-6f; }
      const float d = sqrtf(d2);
      for (int i = bid * 512 + tid; i < 1024 * 1024; i += G * 512) P.out[i] += d; }
#endif
}

extern "C" void kernel_launch(void* const* d_in, const int* in_sizes, int n_in, void* d_out, int out_size, void* d_ws, size_t ws_size, hipStream_t stream) {
    static int grid = 0;
    if (grid == 0) {
        if (n_in != 27 || ws_size < WS_END) { fprintf(stderr, "kernel_launch: unexpected inputs (n_in %d, ws %zu)\n", n_in, ws_size); grid = -1; return; }
        int dev = 0, cus = 0, per_cu = 0;
        hipGetDevice(&dev); hipDeviceGetAttribute(&cus, hipDeviceAttributeMultiprocessorCount, dev);
        hipFuncSetAttribute((const void*)hymba_fwd, hipFuncAttributeMaxDynamicSharedMemorySize, LDS_BYTES);
        hipOccupancyMaxActiveBlocksPerMultiprocessor(&per_cu, (const void*)hymba_fwd, 512, LDS_BYTES);
        if (per_cu < 1) per_cu = 1;
        grid = cus * per_cu;
        fprintf(stderr, "kernel_launch: grid %d (%d CUs x %d)\n", grid, cus, per_cu);
    }
    if (grid < 0) return;
    Params p{};
    for (int i = 0; i < 27; ++i) p.in[i] = (const float*)d_in[i];
    p.out = (float*)d_out; p.ws = (unsigned char*)d_ws;
    void* args[] = {&p};
    hipError_t e = hipLaunchCooperativeKernel((const void*)hymba_fwd, dim3(grid), dim3(512), args, LDS_BYTES, stream);
    if (e != hipSuccess) fprintf(stderr, "kernel_launch: cooperative launch failed: %s (grid %d)\n", hipGetErrorString(e), grid);
}
```
